# Optimizing an MI355X kernel written in HIP

```python
import math
import jax, jax.numpy as jnp
from jax import lax
import numpy as np

D_MODEL = 2048
BATCH = 4
SEQ = 2048
DEPTH = 1

MEM_LEN = 256
D_RNN = 1024
RNN_BLOCKS = 8
RNN_BLOCK = D_RNN // RNN_BLOCKS
CONV_W = 4
LRU_C = 8.0
SWA_HEADS = 16
SWA_KV_HEADS = 2
SWA_GROUP = SWA_HEADS // SWA_KV_HEADS
SWA_HD = 64
D_SWA = SWA_HEADS * SWA_HD
D_SWA_KV = SWA_KV_HEADS * SWA_HD
WINDOW = 128
BLOCK = WINDOW
MEM_HEADS = 4
MEM_HD = 256
D_MEM = MEM_HEADS * MEM_HD
REL_BUCKETS = 32
REL_MAX_DIST = 128
N_BRANCH = 3
EPS = 1e-6
NEG_INF = -1e30

IN_SPLITS = (D_RNN, D_RNN, D_SWA, D_SWA_KV, D_SWA_KV, D_SWA, D_MEM, D_MEM, N_BRANCH * D_MODEL)
D_IN = 2 * D_RNN + 2 * D_SWA + 2 * D_SWA_KV + 2 * D_MEM + N_BRANCH * D_MODEL

kernel_name = "hybrid_rglru_swa_sink_memxattn_gated"


def rmsnorm(x, g):
    xf = x.astype(jnp.float32)
    y = xf * lax.rsqrt(jnp.mean(xf * xf, axis=-1, keepdims=True) + EPS)
    return (y * g.astype(jnp.float32)).astype(x.dtype)


def rel_bucket(dist):
    n = jnp.maximum(dist, 0)
    max_exact = REL_BUCKETS // 2
    ratio = jnp.log(jnp.maximum(n, 1).astype(jnp.float32) / max_exact) / math.log(REL_MAX_DIST / max_exact)
    large = max_exact + (ratio * (REL_BUCKETS - max_exact)).astype(jnp.int32)
    large = jnp.minimum(large, REL_BUCKETS - 1)
    return jnp.where(n < max_exact, n, large)


def rglru_branch(xr, conv_w, conv_b, w_a, b_a, w_x, b_x, lam):
    B, S, _ = xr.shape
    xp = jnp.pad(xr, ((0, 0), (CONV_W - 1, 0), (0, 0)))
    conv = conv_b + sum(xp[:, CONV_W - 1 - k: CONV_W - 1 - k + S] * conv_w[k] for k in range(CONV_W))
    cb = conv.reshape(B, S, RNN_BLOCKS, RNN_BLOCK)
    gate_r = jax.nn.sigmoid((jnp.einsum('bsni,nij->bsnj', cb, w_a).reshape(B, S, D_RNN) + b_a).astype(jnp.float32))
    gate_i = jax.nn.sigmoid((jnp.einsum('bsni,nij->bsnj', cb, w_x).reshape(B, S, D_RNN) + b_x).astype(jnp.float32))
    log_a = -LRU_C * gate_r * jax.nn.softplus(-lam.astype(jnp.float32))
    a = jnp.exp(log_a)
    mult = jnp.sqrt(-jnp.expm1(2.0 * log_a))
    is_start = (jnp.arange(S) == 0)[None, :, None]
    mult = jnp.where(is_start, 1.0, mult)
    b = mult * gate_i * conv.astype(jnp.float32)

    def combine(e1, e2):
        a1, b1 = e1
        a2, b2 = e2
        return a1 * a2, a2 * b1 + b2

    _, h = lax.associative_scan(combine, (a, b), axis=1)
    return h.astype(xr.dtype)


def swa_branch(q, k, v, sinks, rel_bias):
    B, S, _ = q.shape
    nb = S // BLOCK
    q = q.reshape(B, nb, BLOCK, SWA_KV_HEADS, SWA_GROUP, SWA_HD)
    k = k.reshape(B, nb, BLOCK, SWA_KV_HEADS, SWA_HD)
    v = v.reshape(B, nb, BLOCK, SWA_KV_HEADS, SWA_HD)

    def with_prev(t):
        prev = jnp.concatenate([jnp.zeros_like(t[:, :1]), t[:, :-1]], axis=1)
        return jnp.concatenate([prev, t], axis=2)

    kk = with_prev(k)
    vv = with_prev(v)
    logits = jnp.einsum('bnqhgd,bnkhd->bnhgqk', q, kk).astype(jnp.float32) * (SWA_HD ** -0.5)

    qi = jnp.arange(BLOCK)[:, None]
    kj = jnp.arange(2 * BLOCK)[None, :]
    dist = qi + BLOCK - kj
    in_window = (dist >= 0) & (dist < WINDOW)
    key_abs = jnp.arange(nb)[:, None, None] * BLOCK + kj[None] - BLOCK
    valid = in_window[None] & (key_abs >= 0)

    bias = rel_bias.astype(jnp.float32)[rel_bucket(dist)]
    bias = jnp.transpose(bias, (2, 0, 1)).reshape(SWA_KV_HEADS, SWA_GROUP, BLOCK, 2 * BLOCK)
    logits = logits + bias[None, None]
    logits = jnp.where(valid[None, :, None, None], logits, NEG_INF)

    sink = sinks.astype(jnp.float32).reshape(SWA_KV_HEADS, SWA_GROUP)[None, None, :, :, None, None]
    m = jnp.maximum(jnp.max(logits, axis=-1, keepdims=True), sink)
    p = jnp.exp(logits - m)
    denom = jnp.sum(p, axis=-1, keepdims=True) + jnp.exp(sink - m)
    probs = (p / denom).astype(v.dtype)
    out = jnp.einsum('bnhgqk,bnkhd->bnqhgd', probs, vv)
    return out.reshape(B, S, D_SWA)


def mem_branch(q, mk, mv):
    B, S, _ = q.shape
    M = mk.shape[1]
    q = q.reshape(B, S, MEM_HEADS, MEM_HD)
    mk = mk.reshape(B, M, MEM_HEADS, MEM_HD)
    mv = mv.reshape(B, M, MEM_HEADS, MEM_HD)
    logits = jnp.einsum('bshd,bmhd->bhsm', q, mk).astype(jnp.float32) * (MEM_HD ** -0.5)
    probs = jax.nn.softmax(logits, axis=-1).astype(mv.dtype)
    out = jnp.einsum('bhsm,bmhd->bshd', probs, mv)
    return out.reshape(B, S, D_MEM)


def setup_inputs(seed: int = 0) -> dict:
    key = jax.random.key(seed)
    ks = jax.random.split(key, 24)
    f32 = jnp.float32
    nrm = lambda k, shape, s: jax.random.normal(k, shape, f32) * s
    L = DEPTH
    u = jax.random.uniform(ks[12], (L, D_RNN), f32, 0.9, 0.999)
    a0 = u ** (1.0 / LRU_C)
    lru_lambda = jnp.log(a0) - jnp.log1p(-a0)
    return {
        "x": nrm(ks[0], (BATCH, SEQ, D_MODEL), 1.0),
        "mem": nrm(ks[1], (BATCH, MEM_LEN, D_MODEL), 1.0),
        "pre_norm_g": 1.0 + nrm(ks[2], (L, D_MODEL), 0.02),
        "post_norm_g": 1.0 + nrm(ks[3], (L, D_MODEL), 0.02),
        "mem_norm_g": 1.0 + nrm(ks[4], (L, D_MODEL), 0.02),
        "w_in": nrm(ks[5], (L, D_MODEL, D_IN), D_MODEL ** -0.5),
        "conv_w": nrm(ks[6], (L, CONV_W, D_RNN), CONV_W ** -0.5),
        "conv_b": nrm(ks[7], (L, D_RNN), 0.02),
        "w_rg_a": nrm(ks[8], (L, RNN_BLOCKS, RNN_BLOCK, RNN_BLOCK), RNN_BLOCK ** -0.5),
        "b_rg_a": nrm(ks[9], (L, D_RNN), 0.02),
        "w_rg_x": nrm(ks[10], (L, RNN_BLOCKS, RNN_BLOCK, RNN_BLOCK), RNN_BLOCK ** -0.5),
        "b_rg_x": nrm(ks[11], (L, D_RNN), 0.02),
        "lru_lambda": lru_lambda,
        "swa_sinks": nrm(ks[13], (L, SWA_HEADS), 0.5),
        "rel_bias": nrm(ks[14], (REL_BUCKETS, SWA_HEADS), 0.5),
        "w_mem_kv": nrm(ks[15], (L, D_MODEL, 2 * D_MEM), D_MODEL ** -0.5),
        "w_br_rg": nrm(ks[16], (L, D_RNN, D_MODEL), D_RNN ** -0.5),
        "w_br_swa": nrm(ks[17], (L, D_SWA, D_MODEL), D_SWA ** -0.5),
        "w_br_mem": nrm(ks[18], (L, D_MEM, D_MODEL), D_MEM ** -0.5),
        "w_out": nrm(ks[19], (L, D_MODEL, D_MODEL), D_MODEL ** -0.5),
    }


def reference(x, mem, pre_norm_g, post_norm_g, mem_norm_g, w_in, conv_w, conv_b, w_rg_a, b_rg_a,
              w_rg_x, b_rg_x, lru_lambda, swa_sinks, rel_bias, w_mem_kv, w_br_rg, w_br_swa,
              w_br_mem, w_out):
    B, S, D = x.shape
    split_at = np.cumsum(IN_SPLITS)[:-1].tolist()
    for l in range(DEPTH):
        h = rmsnorm(x, pre_norm_g[l])
        proj = jnp.einsum('bsd,de->bse', h, w_in[l])
        (xr, g_rg, q_s, k_s, v_s, g_swa, q_m, g_mem, gate_logits) = jnp.split(proj, split_at, axis=-1)

        y_rg = rglru_branch(xr, conv_w[l], conv_b[l], w_rg_a[l], b_rg_a[l], w_rg_x[l], b_rg_x[l],
                            lru_lambda[l]) * jax.nn.silu(g_rg)
        y_swa = swa_branch(q_s, k_s, v_s, swa_sinks[l], rel_bias) * jax.nn.silu(g_swa)
        memn = rmsnorm(mem, mem_norm_g[l])
        mkv = jnp.einsum('bmd,de->bme', memn, w_mem_kv[l])
        mk, mv = jnp.split(mkv, 2, axis=-1)
        y_mem = mem_branch(q_m, mk, mv) * jax.nn.silu(g_mem)

        gates = jax.nn.sigmoid(gate_logits.astype(jnp.float32)).astype(x.dtype).reshape(B, S, N_BRANCH, D)
        merged = (gates[:, :, 0] * jnp.einsum('bsr,rd->bsd', y_rg, w_br_rg[l])
                  + gates[:, :, 1] * jnp.einsum('bsr,rd->bsd', y_swa, w_br_swa[l])
                  + gates[:, :, 2] * jnp.einsum('bsr,rd->bsd', y_mem, w_br_mem[l]))
        out = jnp.einsum('bsd,de->bse', merged, w_out[l])
        x = x + rmsnorm(out, post_norm_g[l])
    return x
```

```cpp
#include <hip/hip_runtime.h>
#include <cstdio>
#include <cstdint>
namespace pg8 {
#define PG8_LAS __attribute__((address_space(3)))
typedef unsigned short bf16_t;
typedef short bf16x8 __attribute__((ext_vector_type(8)));
typedef float f32x4 __attribute__((ext_vector_type(4)));
typedef unsigned u32x4 __attribute__((ext_vector_type(4)));
constexpr int BM = 256, BK = 64, HALF = 128, HTB = HALF * BK * 2  , STAGE_BYTES = 8 * HTB, NXCD = 8, WGM = 8;

__host__ __device__ __forceinline__ int lds_byte(int r, int c) { const int st = (r >> 4) * 2 + (c >> 5), rr = r & 15, cc = c & 31, ob = rr * 64 + cc * 2; return st * 1024 + (ob ^ (((ob >> 9) & 1) << 5)); }
__host__ __device__ __forceinline__ void stage_rc(int b, int& R, int& C) { const int st = b / 1024, sb = b % 1024, swz = sb ^ (((sb >> 9) & 1) << 5); R = (st >> 1) * 16 + swz / 64; C = (st & 1) * 32 + (swz % 64) / 2; }
__host__ __device__ __forceinline__ int perm32(int rho) { const int n = rho >> 4, i = rho & 15; return 8 * (i >> 2) + 4 * n + (i & 3); }

struct Unit { int pm, pn; };
struct Gemm { const bf16_t* A; const bf16_t* Bt; int M, N, K; };


struct StaticOrder {
    int nM, nN, nwg, G, c;
    __host__ __device__ void init(int M, int N, int G_, int c_) { nM = M / BM; nN = N / BM; nwg = nM * nN; G = G_; c = c_; }
    __host__ __device__ bool next(int i, Unit& u) const {
        const long L = (long)i * G + c; if (L >= nwg) return false;
        int wgid = (int)L; { const int q = nwg / NXCD, r = nwg % NXCD, xcd = wgid % NXCD, off = wgid / NXCD; wgid = (xcd < r ? xcd * (q + 1) : r * (q + 1) + (xcd - r) * q) + off; }
        const int nig = WGM * nN, gid = wgid / nig, fm = gid * WGM, gsz = (nM - fm) < WGM ? (nM - fm) : WGM;
        u.pm = fm + ((wgid % nig) % gsz); u.pn = (wgid % nig) / gsz; return true;
    }
    __device__ __forceinline__ void a_ready(const Unit&) const {}
    __device__ __forceinline__ void done(const Unit&) const {}
};
struct OrderP1 {
    StaticOrder s; int nmain;
    __host__ __device__ void init(int G_, int c_) { s.init(8192, 12544, G_, c_); nmain = s.nwg; }
    __host__ __device__ bool next(int i, Unit& u) const {
        const long L = (long)i * s.G + s.c;
        if (L < nmain) return s.next(i, u);
        const int r = (int)(L - nmain); if (r >= 32) return false;
        u.pm = 32 + (r & 3); u.pn = 49 + (r >> 2); return true;
    }
    __device__ __forceinline__ void a_ready(const Unit&) const {}
    __device__ __forceinline__ void done(const Unit&) const {}
};

__device__ __forceinline__ unsigned cvt_pk_bf16(float lo, float hi) { unsigned r; asm volatile("v_cvt_pk_bf16_f32 %0, %1, %2" : "=v"(r) : "v"(lo), "v"(hi)); return r; }
typedef _Float16 h16x2 __attribute__((ext_vector_type(2)));
__device__ __forceinline__ unsigned pk_f16(float lo, float hi) { h16x2 v = {(_Float16)lo, (_Float16)hi}; return __builtin_bit_cast(unsigned, v); }
__device__ __forceinline__ float f16lo(unsigned w) { h16x2 v = __builtin_bit_cast(h16x2, w); return (float)v.x; }
__device__ __forceinline__ float f16hi(unsigned w) { h16x2 v = __builtin_bit_cast(h16x2, w); return (float)v.y; }
constexpr float LOG2E = 1.4426950408889634f;
__device__ __forceinline__ float sigmoid_f(float v) { return __builtin_amdgcn_rcpf(1.0f + __builtin_amdgcn_exp2f(-LOG2E * v)); }

struct EpiP1 {
    static constexpr bool PERM = true, AFTER_DRAIN = false, HAS_MID = false; static constexpr int MID0 = -1, MID1 = -1;
    bf16_t* PROJ; bf16_t* VT; unsigned short* GATES; bf16_t* MK; bf16_t* MVT;
    __device__ __forceinline__ void mid(f32x4 (&)[2][2][4][2], const Unit&, int, int, int, int, int) const {}
    __device__ __forceinline__ void operator()(const f32x4 (&acc)[2][2][4][2], const Unit& u, int wr, int wc, int fr, int fq) const {
        const int pn = u.pn;
        if (pn < 25) {
            const bool do_silu = (pn >= 4 && pn < 8) || (pn >= 13 && pn < 17) || (pn >= 21);
            const float sc = (pn >= 8 && pn < 12) ? (0.125f * LOG2E) : ((pn >= 17 && pn < 21) ? (0.0625f * LOG2E) : 1.0f);
            const int row0 = u.pm * BM + wr * 64 + fr, col0 = pn * BM + wc * 32 + 8 * fq;
#pragma unroll
            for (int ai = 0; ai < 2; ++ai)
#pragma unroll
                for (int m = 0; m < 4; ++m) { const int row = row0 + ai * HALF + m * 16; bf16_t* rowp = PROJ + (size_t)row * 6400 + col0;
#pragma unroll
                    for (int bj = 0; bj < 2; ++bj) { f32x4 v0 = acc[ai][bj][m][0], v1 = acc[ai][bj][m][1];
                        if (do_silu) {
#pragma unroll
                            for (int j = 0; j < 4; ++j) { v0[j] = v0[j] * sigmoid_f(v0[j]); v1[j] = v1[j] * sigmoid_f(v1[j]); } }
                        else { v0 = v0 * sc; v1 = v1 * sc; }
                        u32x4 w; w.x = cvt_pk_bf16(v0[0], v0[1]); w.y = cvt_pk_bf16(v0[2], v0[3]); w.z = cvt_pk_bf16(v1[0], v1[1]); w.w = cvt_pk_bf16(v1[2], v1[3]);
                        *(u32x4*)(rowp + bj * HALF) = w;
                        if (pn == 12 && bj == 1) {
                            const int b = row >> 11, t = row & 2047, cc = wc * 32 + 8 * fq;
                            bf16_t* vp = VT + ((size_t)((b * 2 + (cc >> 6)) * 64 + (cc & 63)) << 11) + t;
                            vp[0 << 11] = (bf16_t)(w.x & 0xffffu); vp[1 << 11] = (bf16_t)(w.x >> 16); vp[2 << 11] = (bf16_t)(w.y & 0xffffu); vp[3 << 11] = (bf16_t)(w.y >> 16);
                            vp[4 << 11] = (bf16_t)(w.z & 0xffffu); vp[5 << 11] = (bf16_t)(w.z >> 16); vp[6 << 11] = (bf16_t)(w.w & 0xffffu); vp[7 << 11] = (bf16_t)(w.w >> 16);
                        } } }
        } else if (pn < 49) {
            const int gi = pn - 25, br = gi >> 3, ct = gi & 7; const int tid = (wr * 4 + wc) * 64 + fq * 16 + fr;
            unsigned short* base = GATES + (size_t)((u.pm * 8 + ct) * 3 + br) * 65536 + (size_t)tid * 8;
#pragma unroll
            for (int ai = 0; ai < 2; ++ai)
#pragma unroll
                for (int m = 0; m < 4; ++m)
#pragma unroll
                    for (int bj = 0; bj < 2; ++bj) { f32x4 v0 = acc[ai][bj][m][0], v1 = acc[ai][bj][m][1];
#pragma unroll
                        for (int j = 0; j < 4; ++j) { v0[j] = __builtin_fmaxf(sigmoid_f(v0[j]), 6.2e-5f); v1[j] = __builtin_fmaxf(sigmoid_f(v1[j]), 6.2e-5f); }
                        u32x4 w; w.x = pk_f16(v0[0], v0[1]); w.y = pk_f16(v0[2], v0[3]); w.z = pk_f16(v1[0], v1[1]); w.w = pk_f16(v1[2], v1[3]);
                        *(u32x4*)(base + (size_t)((ai * 4 + m) * 2 + bj) * 4096) = w; }
        } else {
            const int pq = pn - 49; const int row0 = (u.pm - 32) * BM + wr * 64 + fr;
#pragma unroll
            for (int ai = 0; ai < 2; ++ai)
#pragma unroll
                for (int m = 0; m < 4; ++m) { const int row = row0 + ai * HALF + m * 16;
#pragma unroll
                    for (int bj = 0; bj < 2; ++bj) { const f32x4 v0 = acc[ai][bj][m][0], v1 = acc[ai][bj][m][1];
                        u32x4 w; w.x = cvt_pk_bf16(v0[0], v0[1]); w.y = cvt_pk_bf16(v0[2], v0[3]); w.z = cvt_pk_bf16(v1[0], v1[1]); w.w = cvt_pk_bf16(v1[2], v1[3]);
                        if (pq < 4) { *(u32x4*)(MK + (size_t)row * 1024 + pq * BM + bj * HALF + wc * 32 + 8 * fq) = w; }
                        else { const int b = row >> 8, mm = row & 255, d0 = bj * HALF + wc * 32 + 8 * fq;
                            bf16_t* vp = MVT + ((size_t)((b * 4 + (pq - 4)) * 256 + d0) << 8) + mm;
                            vp[0 << 8] = (bf16_t)(w.x & 0xffffu); vp[1 << 8] = (bf16_t)(w.x >> 16); vp[2 << 8] = (bf16_t)(w.y & 0xffffu); vp[3 << 8] = (bf16_t)(w.y >> 16);
                            vp[4 << 8] = (bf16_t)(w.z & 0xffffu); vp[5 << 8] = (bf16_t)(w.z >> 16); vp[6 << 8] = (bf16_t)(w.w & 0xffffu); vp[7 << 8] = (bf16_t)(w.w >> 16); } } }
        }
    }
};

struct EpiP3 {
    static constexpr bool PERM = true, AFTER_DRAIN = false, HAS_MID = true; static constexpr int MID0 = 16, MID1 = 32;
    const unsigned short* GATES; bf16_t* MERGED;
    __device__ __forceinline__ void mid(f32x4 (&acc)[2][2][4][2], const Unit& u, int t, int wr, int wc, int fr, int fq) const {
        const int br = (t == MID0) ? 0 : 1; const int tid = (wr * 4 + wc) * 64 + fq * 16 + fr;
        const unsigned short* g0 = GATES + (size_t)((u.pm * 8 + u.pn) * 3 + br) * 65536 + (size_t)tid * 8; const unsigned short* g1 = g0 + 65536;
#pragma unroll
        for (int ai = 0; ai < 2; ++ai)
#pragma unroll
            for (int m = 0; m < 4; ++m)
#pragma unroll
                for (int bj = 0; bj < 2; ++bj) { const size_t off = (size_t)((ai * 4 + m) * 2 + bj) * 4096;
                    const u32x4 a = *(const u32x4*)(g0 + off), b = *(const u32x4*)(g1 + off);
                    f32x4 r0, r1;
                    r0[0] = f16lo(a.x) * __builtin_amdgcn_rcpf(f16lo(b.x)); r0[1] = f16hi(a.x) * __builtin_amdgcn_rcpf(f16hi(b.x));
                    r0[2] = f16lo(a.y) * __builtin_amdgcn_rcpf(f16lo(b.y)); r0[3] = f16hi(a.y) * __builtin_amdgcn_rcpf(f16hi(b.y));
                    r1[0] = f16lo(a.z) * __builtin_amdgcn_rcpf(f16lo(b.z)); r1[1] = f16hi(a.z) * __builtin_amdgcn_rcpf(f16hi(b.z));
                    r1[2] = f16lo(a.w) * __builtin_amdgcn_rcpf(f16lo(b.w)); r1[3] = f16hi(a.w) * __builtin_amdgcn_rcpf(f16hi(b.w));
                    acc[ai][bj][m][0] = acc[ai][bj][m][0] * r0; acc[ai][bj][m][1] = acc[ai][bj][m][1] * r1; }
    }
    __device__ __forceinline__ void operator()(const f32x4 (&acc)[2][2][4][2], const Unit& u, int wr, int wc, int fr, int fq) const {
        const int tid = (wr * 4 + wc) * 64 + fq * 16 + fr;
        const unsigned short* g2 = GATES + (size_t)((u.pm * 8 + u.pn) * 3 + 2) * 65536 + (size_t)tid * 8;
        const int row0 = u.pm * BM + wr * 64 + fr, col0 = u.pn * BM + wc * 32 + 8 * fq;
#pragma unroll
        for (int ai = 0; ai < 2; ++ai)
#pragma unroll
            for (int m = 0; m < 4; ++m) { bf16_t* rowp = MERGED + (size_t)(row0 + ai * HALF + m * 16) * 2048 + col0;
#pragma unroll
                for (int bj = 0; bj < 2; ++bj) { const u32x4 a = *(const u32x4*)(g2 + (size_t)((ai * 4 + m) * 2 + bj) * 4096);
                    f32x4 v0 = acc[ai][bj][m][0], v1 = acc[ai][bj][m][1];
                    v0[0] *= f16lo(a.x); v0[1] *= f16hi(a.x); v0[2] *= f16lo(a.y); v0[3] *= f16hi(a.y);
                    v1[0] *= f16lo(a.z); v1[1] *= f16hi(a.z); v1[2] *= f16lo(a.w); v1[3] *= f16hi(a.w);
                    u32x4 w; w.x = cvt_pk_bf16(v0[0], v0[1]); w.y = cvt_pk_bf16(v0[2], v0[3]); w.z = cvt_pk_bf16(v1[0], v1[1]); w.w = cvt_pk_bf16(v1[2], v1[3]);
                    *(u32x4*)(rowp + bj * HALF) = w; } }
    }
};

struct EpiF32 {
    static constexpr bool PERM = false, AFTER_DRAIN = false, HAS_MID = false; static constexpr int MID0 = -1, MID1 = -1;
    float* C; int ldc;
    __device__ __forceinline__ void mid(f32x4 (&)[2][2][4][2], const Unit&, int, int, int, int, int) const {}
    __device__ __forceinline__ void operator()(const f32x4 (&acc)[2][2][4][2], const Unit& u, int wr, int wc, int fr, int fq) const {
        const int row0 = u.pm * BM + wr * 64 + fr, col0 = u.pn * BM + wc * 32 + 4 * fq;
#pragma unroll
        for (int ai = 0; ai < 2; ++ai)
#pragma unroll
            for (int m = 0; m < 4; ++m) { float* rowp = C + (size_t)(row0 + ai * HALF + m * 16) * ldc + col0;
#pragma unroll
                for (int bj = 0; bj < 2; ++bj)
#pragma unroll
                    for (int n = 0; n < 2; ++n) *(f32x4*)(rowp + bj * HALF + n * 16) = acc[ai][bj][m][n]; }
    }
};

template <class Epi, class Sched, bool ALIGN_EPI = false, bool SP2 = false>
__device__ __forceinline__ void gemm_phase(PG8_LAS unsigned char* lds, const Gemm g, const Sched& S, const Epi& E) {
    const int tid = threadIdx.x, wid = __builtin_amdgcn_readfirstlane(tid >> 6), lane = tid & 63, wr = wid >> 2, wc = wid & 3, fr = lane & 15, fq = lane >> 4;
    const int K = g.K, nt = K / BK;
    unsigned voffA[2], voffB[2];
#pragma unroll
    for (int i = 0; i < 2; ++i) { int R, C; stage_rc(tid * 16 + i * 8192, R, C); const int Rb = Epi::PERM ? ((R & ~31) + perm32(R & 31)) : R;
        voffA[i] = (unsigned)(R * K + C) * 2u; voffB[i] = (unsigned)(Rb * K + C) * 2u; }
    const size_t kstep = (size_t)(BK * 2);
    const size_t hstep = (size_t)HALF * K * 2;
    const size_t tstep = 2 * hstep;
    const unsigned ldsw = (unsigned)wid * 1024u;
    const int aoff = lds_byte(wr * 64 + fr, fq * 8), boff = lds_byte(wc * 32 + fr, fq * 8);
#define PG8_SA(b, h) (((b) * 2 + (h)) * HTB)
#define PG8_SB(b, h) ((4 + (b) * 2 + (h)) * HTB)
#define PG8_STAGE(bufoff, gbase, voff) do { _Pragma("unroll") for (int _i = 0; _i < 2; ++_i) \
        __builtin_amdgcn_global_load_lds((const unsigned*)((const char*)(gbase) + (voff)[_i]), (PG8_LAS unsigned*)(lds + (bufoff) + ldsw + _i * 8192), 16, 0, 0); } while (0)
#define PG8_LDA(dst, b, h) do { _Pragma("unroll") for (int m = 0; m < 4; ++m) _Pragma("unroll") for (int k = 0; k < 2; ++k) dst[m][k] = *(const PG8_LAS bf16x8*)(lds + PG8_SA(b, h) + aoff + m * 2048 + k * 1024); } while (0)
#define PG8_LDB(dst, b, h) do { _Pragma("unroll") for (int n = 0; n < 2; ++n) _Pragma("unroll") for (int k = 0; k < 2; ++k) dst[n][k] = *(const PG8_LAS bf16x8*)(lds + PG8_SB(b, h) + boff + n * 2048 + k * 1024); } while (0)
#define PG8_MMA(ai, bj, At, Bt) do { __builtin_amdgcn_s_setprio(1); _Pragma("unroll") for (int m = 0; m < 4; ++m) _Pragma("unroll") for (int n = 0; n < 2; ++n) _Pragma("unroll") for (int k = 0; k < 2; ++k) \
        acc[ai][bj][m][n] = __builtin_amdgcn_mfma_f32_16x16x32_bf16(Bt[n][k], At[m][k], acc[ai][bj][m][n], 0, 0, 0); __builtin_amdgcn_s_setprio(0); } while (0)
#define PG8_WAIT_V(n) asm volatile("s_waitcnt vmcnt(" #n ")" ::: "memory")
#define PG8_WAIT_L(n) asm volatile("s_waitcnt lgkmcnt(" #n ")" ::: "memory")
#define PG8_BAR __builtin_amdgcn_s_barrier()
#define PG8_SCHED __builtin_amdgcn_sched_barrier(0)
    Unit cur, nxt; int ui = 0;
    if (!S.next(0, cur)) return;
    f32x4 acc[2][2][4][2];
#pragma unroll
    for (int a = 0; a < 2; ++a)
#pragma unroll
        for (int b = 0; b < 2; ++b)
#pragma unroll
            for (int m = 0; m < 4; ++m)
#pragma unroll
                for (int n = 0; n < 2; ++n) acc[a][b][m][n] = (f32x4){0.f, 0.f, 0.f, 0.f};
    bf16x8 At[4][2], B0[2][2], B1[2][2];
    const char* cA = (const char*)g.A + (size_t)cur.pm * tstep; const char* cB = (const char*)g.Bt + (size_t)cur.pn * tstep;
    S.a_ready(cur);
    if constexpr (SP2) {
        PG8_STAGE(PG8_SB(0, 0), cB, voffB); PG8_STAGE(PG8_SB(0, 1), cB + hstep, voffB); PG8_STAGE(PG8_SA(0, 0), cA, voffA); PG8_STAGE(PG8_SA(0, 1), cA + hstep, voffA);
        if (wr == 1) PG8_BAR;
        PG8_WAIT_V(2); PG8_BAR;
        PG8_STAGE(PG8_SB(1, 0), cB + kstep, voffB); PG8_STAGE(PG8_SA(1, 0), cA + kstep, voffA); PG8_STAGE(PG8_SB(1, 1), cB + hstep + kstep, voffB);
        PG8_WAIT_V(6); PG8_BAR;
    } else {
        PG8_STAGE(PG8_SB(0, 0), cB, voffB); PG8_STAGE(PG8_SA(0, 0), cA, voffA); PG8_STAGE(PG8_SB(0, 1), cB + hstep, voffB); PG8_STAGE(PG8_SA(0, 1), cA + hstep, voffA);
        if (wr == 1) PG8_BAR;
        PG8_WAIT_V(4); PG8_BAR;
        PG8_STAGE(PG8_SB(1, 0), cB + kstep, voffB); PG8_STAGE(PG8_SA(1, 0), cA + kstep, voffA); PG8_STAGE(PG8_SB(1, 1), cB + hstep + kstep, voffB);
        PG8_WAIT_V(6); PG8_BAR;
    }
    for (;;) {
        const bool has_next = S.next(ui + 1, nxt);
        const char* nA = has_next ? (const char*)g.A + (size_t)nxt.pm * tstep : cA; const char* nB = has_next ? (const char*)g.Bt + (size_t)nxt.pn * tstep : cB;
        for (int t = 0; t < nt; t += 2) {
            const bool last = (t == nt - 2);
            if constexpr (Epi::HAS_MID) { if (t == Epi::MID0 || t == Epi::MID1) E.mid(acc, cur, t, wr, wc, fr, fq); }
            const char* a1 = cA + (size_t)(t + 1) * kstep;
            const char* a2 = last ? nA : cA + (size_t)(t + 2) * kstep; const char* b2 = last ? nB : cB + (size_t)(t + 2) * kstep;
            const char* a3 = a2 + kstep; const char* b3 = b2 + kstep;
            if (last && has_next) S.a_ready(nxt);
            if constexpr (SP2) {
            PG8_LDB(B0, 0, 0); PG8_LDB(B1, 0, 1); PG8_SCHED; PG8_LDA(At, 0, 0); PG8_STAGE(PG8_SA(1, 1), a1 + hstep, voffA);
            PG8_WAIT_V(8); PG8_WAIT_L(0); PG8_BAR; PG8_MMA(0, 0, At, B0); PG8_MMA(0, 1, At, B1); PG8_BAR; PG8_SCHED;
            PG8_LDA(At, 0, 1); PG8_STAGE(PG8_SB(0, 0), b2, voffB); PG8_STAGE(PG8_SB(0, 1), b2 + hstep, voffB); PG8_STAGE(PG8_SA(0, 0), a2, voffA);
            PG8_WAIT_V(8); PG8_WAIT_L(0); PG8_BAR; PG8_MMA(1, 0, At, B0); PG8_MMA(1, 1, At, B1); PG8_BAR; PG8_SCHED;
            PG8_LDB(B0, 1, 0); PG8_LDB(B1, 1, 1); PG8_SCHED; PG8_LDA(At, 1, 0); PG8_STAGE(PG8_SA(0, 1), a2 + hstep, voffA);
            PG8_WAIT_V(8); PG8_WAIT_L(0); PG8_BAR; PG8_MMA(0, 0, At, B0); PG8_MMA(0, 1, At, B1); PG8_BAR; PG8_SCHED;
            PG8_LDA(At, 1, 1); PG8_STAGE(PG8_SB(1, 0), b3, voffB); PG8_STAGE(PG8_SB(1, 1), b3 + hstep, voffB); PG8_STAGE(PG8_SA(1, 0), a3, voffA);
            PG8_WAIT_V(8); PG8_WAIT_L(0); PG8_BAR; PG8_MMA(1, 0, At, B0); PG8_MMA(1, 1, At, B1); PG8_BAR; PG8_SCHED;
            } else {
            PG8_LDB(B0, 0, 0); PG8_SCHED; PG8_LDA(At, 0, 0); PG8_STAGE(PG8_SA(1, 1), a1 + hstep, voffA);
            PG8_WAIT_L(8); PG8_BAR; PG8_WAIT_L(0); PG8_MMA(0, 0, At, B0); PG8_BAR; PG8_SCHED;
            PG8_LDB(B1, 0, 1); PG8_STAGE(PG8_SB(0, 0), b2, voffB);
            PG8_BAR; PG8_WAIT_L(0); PG8_MMA(0, 1, At, B1); PG8_BAR;
            PG8_LDA(At, 0, 1); PG8_STAGE(PG8_SA(0, 0), a2, voffA);
            PG8_BAR; PG8_WAIT_L(0); PG8_MMA(1, 0, At, B0); PG8_BAR; PG8_SCHED;
            PG8_STAGE(PG8_SB(0, 1), b2 + hstep, voffB);
            PG8_WAIT_V(6); PG8_BAR; PG8_MMA(1, 1, At, B1); PG8_BAR;
            PG8_LDB(B0, 1, 0); PG8_SCHED; PG8_LDA(At, 1, 0); PG8_STAGE(PG8_SA(0, 1), a2 + hstep, voffA);
            PG8_WAIT_L(8); PG8_BAR; PG8_WAIT_L(0); PG8_MMA(0, 0, At, B0); PG8_BAR; PG8_SCHED;
            PG8_LDB(B1, 1, 1); PG8_STAGE(PG8_SB(1, 0), b3, voffB);
            PG8_BAR; PG8_WAIT_L(0); PG8_MMA(0, 1, At, B1); PG8_BAR;
            PG8_LDA(At, 1, 1); PG8_STAGE(PG8_SA(1, 0), a3, voffA);
            PG8_BAR; PG8_WAIT_L(0); PG8_MMA(1, 0, At, B0); PG8_BAR; PG8_SCHED;
            PG8_STAGE(PG8_SB(1, 1), b3 + hstep, voffB);
            PG8_WAIT_V(6); PG8_BAR; PG8_MMA(1, 1, At, B1); PG8_BAR;
            }
        }
        if constexpr (ALIGN_EPI) { if (wr == 0) PG8_BAR; }
        if constexpr (!Epi::AFTER_DRAIN) { E(acc, cur, wr, wc, fr, fq); S.done(cur); }
        if (!has_next) break;
#pragma unroll
        for (int a = 0; a < 2; ++a)
#pragma unroll
            for (int b = 0; b < 2; ++b)
#pragma unroll
                for (int m = 0; m < 4; ++m)
#pragma unroll
                    for (int n = 0; n < 2; ++n) acc[a][b][m][n] = (f32x4){0.f, 0.f, 0.f, 0.f};
        cur = nxt; cA = nA; cB = nB; ++ui;
        if constexpr (ALIGN_EPI) { if (wr == 1) PG8_BAR; }
    }
    PG8_WAIT_V(0);
    if constexpr (!ALIGN_EPI) { if (wr == 0) PG8_BAR; }
    PG8_BAR;
    if constexpr (Epi::AFTER_DRAIN) { E.fused(acc, cur, wr, wc, fr, fq, lds, wid, lane); S.done(cur); }
#undef PG8_SA
#undef PG8_SB
#undef PG8_STAGE
#undef PG8_LDA
#undef PG8_LDB
#undef PG8_MMA
#undef PG8_WAIT_V
#undef PG8_WAIT_L
#undef PG8_BAR
#undef PG8_SCHED
}
}

#ifndef PG8_SP2
#define PG8_SP2 true
#endif
#ifndef PG8_ALIGN
#define PG8_ALIGN true
#endif
#define GAS __attribute__((address_space(1)))
#define LAS __attribute__((address_space(3)))
typedef unsigned short bf16;
typedef unsigned v4u __attribute__((ext_vector_type(4)));
typedef float f32x4 __attribute__((ext_vector_type(4)));
typedef short bf16x8 __attribute__((ext_vector_type(8)));
typedef GAS unsigned gu32;
typedef GAS unsigned long long gu64;
#define RLX_AGENT __ATOMIC_RELAXED, __HIP_MEMORY_SCOPE_AGENT
#define LDS_WAIT() asm volatile("s_waitcnt lgkmcnt(0)" ::: "memory")
#define VM_WAIT() asm volatile("s_waitcnt vmcnt(0)" ::: "memory")
__device__ __forceinline__ unsigned long long rt() { return __builtin_amdgcn_s_memrealtime(); }
__device__ __forceinline__ unsigned f2bf(float f) { unsigned u = __builtin_bit_cast(unsigned, f); return (u + 0x7fffu + ((u >> 16) & 1u)) >> 16; }
__device__ __forceinline__ unsigned pk2(float lo, float hi) { return f2bf(lo) | (f2bf(hi) << 16); }

#define XB_TMO      128
#define XB_XCNT(j)  (256  + 64 * (j))
#define XB_XSUB(j)  (1280 + 64 * (j))
#define XB_XGEN(j)  (2304 + 64 * (j))
#define XB_TOP      3328
#define XB_TOPGEN   3392
#define XCD_BAR_WORDS 3456
#define XB_SPIN_CAP (1u << 18)

__device__ __forceinline__ unsigned xb_ld(unsigned* p)              { return __hip_atomic_load(p, __ATOMIC_RELAXED, __HIP_MEMORY_SCOPE_AGENT); }
__device__ __forceinline__ unsigned xb_add(unsigned* p, unsigned v) { return __hip_atomic_fetch_add(p, v, __ATOMIC_RELAXED, __HIP_MEMORY_SCOPE_AGENT); }
__device__ __forceinline__ unsigned xb_xcc_id() { return (unsigned)__builtin_amdgcn_s_getreg((3 << 11) | 20) & 0xFu; }
#define XB_SPIN(cond, bar) do { unsigned _sp = 0; while (cond) { __builtin_amdgcn_s_sleep(1); \
    if ((++_sp & 255u) == 0u) { if (xb_ld(&(bar)[XB_TMO])) break; if (_sp > XB_SPIN_CAP) { atomicAdd(&(bar)[XB_TMO], 1u); break; } } } } while (0)

struct XcdBarrier {
    unsigned* bar; unsigned x;
    volatile LAS unsigned* st;
};

__device__ __forceinline__ XcdBarrier xcd_barrier_post(unsigned* bar, volatile LAS unsigned* st) {
    XcdBarrier b; b.bar = bar; b.x = xb_xcc_id(); b.st = st;
    if (threadIdx.x == 0) (void)xb_add(&bar[XB_XCNT(b.x)], 1u);
    return b;
}
__device__ __forceinline__ void xcd_barrier_complete(unsigned* bar, unsigned x, unsigned& nloc, unsigned& nx) {
    const unsigned G = gridDim.x * gridDim.y * gridDim.z;
    unsigned sum, cnt, mine, sp = 0u;
    for (;;) {
        sum = 0u; cnt = 0u; mine = 0u;
#pragma unroll
        for (unsigned j = 0; j < 16; ++j) { const unsigned c = xb_ld(&bar[XB_XCNT(j)]); sum += c; cnt += (c > 0u) ? 1u : 0u; mine = (j == x) ? c : mine; }
        if (sum == G) break;
        __builtin_amdgcn_s_sleep(1);
        if ((++sp & 255u) == 0u) { if (xb_ld(&bar[XB_TMO])) break; if (sp > XB_SPIN_CAP) { atomicAdd(&bar[XB_TMO], 1u); break; } }
    }
    nloc = mine > 0u ? mine : 1u; nx = cnt > 0u ? cnt : 1u;
}

__device__ __forceinline__ void xcd_barrier(const XcdBarrier& b) {
    asm volatile("s_waitcnt vmcnt(0)" ::: "memory");
    __syncthreads();
    if (threadIdx.x == 0) {
        unsigned* bar = b.bar;
        __builtin_amdgcn_s_waitcnt(0);
        unsigned nloc = b.st[0], nx = b.st[1];
        if (nloc == 0u) { xcd_barrier_complete(bar, b.x, nloc, nx); b.st[0] = nloc; b.st[1] = nx; }
        const unsigned old = xb_add(&bar[XB_XSUB(b.x)], 1u);
        const unsigned gen = old / nloc;
        if (old + 1u == (gen + 1u) * nloc) {
            __builtin_amdgcn_fence(__ATOMIC_RELEASE, "agent");
            asm volatile("s_waitcnt vmcnt(0)" ::: "memory");
            const unsigned og = xb_add(&bar[XB_TOP], 1u);
            const unsigned tg = og / nx;
            if (og + 1u == (tg + 1u) * nx) xb_add(&bar[XB_TOPGEN], 1u);
            else XB_SPIN(xb_ld(&bar[XB_TOPGEN]) == tg, bar);
            __builtin_amdgcn_fence(__ATOMIC_ACQUIRE, "agent");
            xb_add(&bar[XB_XGEN(b.x)], 1u);
            asm volatile("s_waitcnt vmcnt(0)" ::: "memory");
        } else {
            XB_SPIN(xb_ld(&bar[XB_XGEN(b.x)]) == gen, bar);
            __builtin_amdgcn_fence(__ATOMIC_ACQUIRE, "agent");
            asm volatile("s_waitcnt vmcnt(0)" ::: "memory");
        }
    }
    __syncthreads();
}


constexpr int NWAVES = 8;
constexpr int BATCH = 4, SEQ = 2048, DM = 2048, TOK = BATCH * SEQ, MEML = 256, MROWS = BATCH * MEML;
constexpr int D_RNN = 1024, D_IN = 12544, PLD = 6400, YLD = 3072;
constexpr int C_XR = 0, C_GRG = 1024, C_QS = 2048, C_KS = 3072, C_VS = 3200, C_GSWA = 3328, C_QM = 4352, C_GMEM = 5376;
constexpr float EPS = 1e-6f;
constexpr float LOG2E = 1.4426950408889634f;
__device__ const unsigned char REL_BUCKET[128] = {0, 1, 2, 3, 4, 5, 6, 7, 8, 9, 10, 11, 12, 13, 14, 15, 16, 16, 16, 17, 17, 18, 18, 18, 19, 19, 19, 20, 20, 20, 20, 21, 21, 21, 21, 22, 22, 22, 22, 22, 23, 23, 23, 23, 23, 23, 24, 24, 24, 24, 24, 24, 25, 25, 25, 25, 25, 25, 25, 26, 26, 26, 26, 26, 26, 26, 26, 27, 27, 27, 27, 27, 27, 27, 27, 27, 27, 28, 28, 28, 28, 28, 28, 28, 28, 28, 28, 29, 29, 29, 29, 29, 29, 29, 29, 29, 29, 29, 29, 30, 30, 30, 30, 30, 30, 30, 30, 30, 30, 30, 30, 30, 30, 31, 31, 31, 31, 31, 31, 31, 31, 31, 31, 31, 31, 31, 31, 31};

constexpr size_t MiB = 1u << 20;
constexpr size_t WS_CTL = 0, CTL_ZERO_BYTES = 1 * MiB;
constexpr size_t WS_WIN = 2 * MiB;
constexpr size_t WS_WMKV = 51 * MiB;
constexpr size_t WS_WBR = 59 * MiB;
constexpr size_t WS_WOUT = 71 * MiB;
constexpr size_t WS_H = 80 * MiB;
constexpr size_t WS_MEMN = 112 * MiB;
constexpr size_t WS_PROJ = 116 * MiB;
constexpr size_t WS_VT = 216 * MiB;
constexpr size_t WS_MK = 218 * MiB;
constexpr size_t WS_MVT = 220 * MiB;
constexpr size_t WS_GATES = 222 * MiB;
constexpr size_t WS_Y = 318 * MiB;
constexpr size_t WS_MERGED = WS_H;
constexpr size_t WS_OUT32 = WS_PROJ;
constexpr size_t WS_END = 366 * MiB;
static_assert(WS_WIN + (size_t)12544 * 2048 * 2 == WS_WMKV && WS_H + (size_t)TOK * DM * 2 == WS_MEMN && WS_PROJ + (size_t)TOK * PLD * 2 == WS_VT && WS_GATES + (size_t)768 * 131072 == WS_Y && WS_Y + (size_t)TOK * YLD * 2 == WS_END, "d_ws map");
constexpr int CW_TMO = 0, CW_CODE = 1;
constexpr int CW_BAR = 4096;

constexpr int RING_OFF = 0, RING_BYTES = 131072;
constexpr int LDSCTL_OFF = RING_BYTES, MISC_OFF = LDSCTL_OFF + 320;
constexpr int LDS_BYTES = 147456;
static_assert(MISC_OFF + 128 <= LDS_BYTES, "LDS map");


struct Frame {
    LAS unsigned char* lds;
    volatile LAS unsigned* MISC;
    gu32* ctl;
    int tid, lane, wave;
    int vcu, G;
    const float* in[20]; float* out; unsigned char* ws;
};
__device__ __forceinline__ float wave_sum(float v) {
#pragma unroll
    for (int o = 1; o < 64; o <<= 1) v += __shfl_xor(v, o);
    return v;
}
__device__ __forceinline__ float wave_max(float v) {
#pragma unroll
    for (int o = 1; o < 64; o <<= 1) v = __builtin_fmaxf(v, __shfl_xor(v, o));
    return v;
}
__device__ __forceinline__ float bf2f(bf16 u) { return __uint_as_float((unsigned)u << 16); }
__device__ __forceinline__ float bflo(unsigned w) { return __uint_as_float(w << 16); }
__device__ __forceinline__ float bfhi(unsigned w) { return __uint_as_float(w & 0xffff0000u); }

__device__ __forceinline__ void p0_transpose_item(const float* W, int N, bf16* WT, int ldt, int col_off, LAS float* scr, int item, int lane) {
    const int nblk = N / 32, kb = item / nblk, nb = item % nblk, k0 = 64 * kb, n0 = 32 * nb;
#pragma unroll 8
    for (int i = 0; i < 32; ++i) { const int kk = 2 * i + (lane >> 5); scr[kk * 33 + (lane & 31)] = W[(size_t)(k0 + kk) * N + n0 + (lane & 31)]; }
    LDS_WAIT(); asm volatile("" ::: "memory");
    const int c = lane & 7;
#pragma unroll
    for (int j = 0; j < 4; ++j) { const int n = (lane >> 3) + 8 * j; const LAS float* s = scr + (8 * c) * 33 + n;
        v4u o; o.x = pk2(s[0 * 33], s[1 * 33]); o.y = pk2(s[2 * 33], s[3 * 33]); o.z = pk2(s[4 * 33], s[5 * 33]); o.w = pk2(s[6 * 33], s[7 * 33]);
        *(GAS v4u*)(WT + (size_t)(n0 + n) * ldt + col_off + k0 + 8 * c) = o; }
    LDS_WAIT(); asm volatile("" ::: "memory");
}
__device__ __forceinline__ void rms_row_to_bf16(int lane, const float* xrow, const float* g, bf16* orow) {
    const GAS f32x4* xr = (const GAS f32x4*)xrow + lane; const GAS f32x4* gr = (const GAS f32x4*)g + lane;
    f32x4 v[8]; float s = 0.f;
#pragma unroll
    for (int j = 0; j < 8; ++j) { v[j] = xr[64 * j]; s += (v[j].x * v[j].x + v[j].y * v[j].y) + (v[j].z * v[j].z + v[j].w * v[j].w); }
    const float rstd = 1.0f / sqrtf(wave_sum(s) * (1.f / DM) + EPS);
    GAS unsigned long long* o8 = (GAS unsigned long long*)orow + lane;
#pragma unroll
    for (int j = 0; j < 8; ++j) { const f32x4 gg = gr[64 * j];
        o8[64 * j] = (unsigned long long)pk2(v[j].x * rstd * gg.x, v[j].y * rstd * gg.y) | ((unsigned long long)pk2(v[j].z * rstd * gg.z, v[j].w * rstd * gg.w) << 32); }
}
__device__ __forceinline__ void p0_prologue(Frame& F) {
    LAS float* scr = (LAS float*)(F.lds + RING_OFF + F.wave * 16384);
    const int gw = F.vcu * NWAVES + F.wave, NGW = F.G * NWAVES;
    constexpr int I_IN = (DM / 64) * (D_IN / 32), I_MKV = (DM / 64) * (2048 / 32), I_BR = (1024 / 64) * (DM / 32), I_OUT = (DM / 64) * (DM / 32);
    constexpr int NITEMS = I_IN + I_MKV + 3 * I_BR + I_OUT;
    bf16* WinT = (bf16*)(F.ws + WS_WIN); bf16* WmkvT = (bf16*)(F.ws + WS_WMKV); bf16* WbrT = (bf16*)(F.ws + WS_WBR); bf16* WoutT = (bf16*)(F.ws + WS_WOUT);
    for (int it = gw; it < NITEMS; it += NGW) {
        int r = it;
        if (r < I_IN) { p0_transpose_item(F.in[5], D_IN, WinT, DM, 0, scr, r, F.lane); continue; } r -= I_IN;
        if (r < I_MKV) { p0_transpose_item(F.in[15], 2048, WmkvT, DM, 0, scr, r, F.lane); continue; } r -= I_MKV;
        if (r < I_BR) { p0_transpose_item(F.in[16], DM, WbrT, YLD, 0, scr, r, F.lane); continue; } r -= I_BR;
        if (r < I_BR) { p0_transpose_item(F.in[17], DM, WbrT, YLD, 1024, scr, r, F.lane); continue; } r -= I_BR;
        if (r < I_BR) { p0_transpose_item(F.in[18], DM, WbrT, YLD, 2048, scr, r, F.lane); continue; } r -= I_BR;
        p0_transpose_item(F.in[19], DM, WoutT, DM, 0, scr, r, F.lane);
    }
    bf16* H = (bf16*)(F.ws + WS_H); bf16* MEMN = (bf16*)(F.ws + WS_MEMN);
    for (int m = gw; m < TOK; m += NGW) rms_row_to_bf16(F.lane, F.in[0] + (size_t)m * DM, F.in[2], H + (size_t)m * DM);
    for (int m = gw; m < MROWS; m += NGW) rms_row_to_bf16(F.lane, F.in[1] + (size_t)m * DM, F.in[4], MEMN + (size_t)m * DM);
}

__device__ __forceinline__ void p2_rglru_gates_naive(Frame& F) {
    const bf16* PROJ = (const bf16*)(F.ws + WS_PROJ); float* AB = F.out;
    const float* conv_w = F.in[6]; const float* conv_b = F.in[7]; const float* w_a = F.in[8]; const float* b_a = F.in[9]; const float* w_x = F.in[10]; const float* b_x = F.in[11]; const float* lam = F.in[12];
    LAS float* cb = (LAS float*)(F.lds) + F.wave * 128;
    const int gw = F.vcu * NWAVES + F.wave, NGW = F.G * NWAVES, lane = F.lane;
    for (int task = gw; task < TOK * 8; task += NGW) {
        const int row = task >> 3, n = task & 7, t = row & (SEQ - 1);
        float cv[2];
#pragma unroll
        for (int q = 0; q < 2; ++q) { const int c = n * 128 + lane + 64 * q; float s = conv_b[c];
#pragma unroll
            for (int k = 0; k < 4; ++k) if (t - k >= 0) s += conv_w[k * 1024 + c] * bf2f(PROJ[(size_t)(row - k) * PLD + C_XR + c]);
            cv[q] = s; cb[lane + 64 * q] = s; }
        LDS_WAIT(); asm volatile("" ::: "memory");
        float ga[2], gx[2];
#pragma unroll
        for (int q = 0; q < 2; ++q) { const int c = n * 128 + lane + 64 * q; ga[q] = b_a[c]; gx[q] = b_x[c]; }
        for (int i = 0; i < 128; ++i) { const float x = cb[i];
#pragma unroll
            for (int q = 0; q < 2; ++q) { const int j = lane + 64 * q; ga[q] += x * w_a[(size_t)(n * 128 + i) * 128 + j]; gx[q] += x * w_x[(size_t)(n * 128 + i) * 128 + j]; } }
#pragma unroll
        for (int q = 0; q < 2; ++q) { const int c = n * 128 + lane + 64 * q;
            const float r = 1.0f / (1.0f + expf(-ga[q])), ii = 1.0f / (1.0f + expf(-gx[q]));
            const float sp = log1pf(expf(-lam[c]));
            const float log_a = -8.0f * r * sp, a = expf(log_a);
            const float mult = (t == 0) ? 1.0f : sqrtf(-expm1f(2.0f * log_a));
            const float bb = mult * ii * cv[q];
            *(float2*)(AB + ((size_t)row * 1024 + c) * 2) = make_float2(a, bb); }
        LDS_WAIT(); asm volatile("" ::: "memory");
    }
}
__device__ __forceinline__ void p2_rglru_scan_naive(Frame& F) {
    const bf16* PROJ = (const bf16*)(F.ws + WS_PROJ); const float* AB = F.out; bf16* Y = (bf16*)(F.ws + WS_Y);
    const int gid = F.vcu * (NWAVES * 64) + F.tid;
    if (gid < BATCH * 1024) {
        const int b = gid >> 10, c = gid & 1023; float h = 0.f;
#pragma unroll 8
        for (int t = 0; t < SEQ; ++t) { const size_t row = (size_t)b * SEQ + t; const float2 ab = *(const float2*)(AB + (row * 1024 + c) * 2);
            h = ab.x * h + ab.y; if (t == 0) h = ab.y;
            Y[row * YLD + c] = (bf16)f2bf(h * bf2f(PROJ[row * PLD + C_GRG + c])); }
    }
}
__device__ __forceinline__ void p2_swa_naive(Frame& F) {
    const bf16* PROJ = (const bf16*)(F.ws + WS_PROJ); const bf16* VT = (const bf16*)(F.ws + WS_VT); bf16* Y = (bf16*)(F.ws + WS_Y);
    const float* sinks = F.in[13]; const float* rel_bias = F.in[14];
    const int gw = F.vcu * NWAVES + F.wave, NGW = F.G * NWAVES, lane = F.lane;
    for (int task = gw; task < TOK * 16; task += NGW) {
        const int row = task >> 4, h = task & 15, kvh = h >> 3, b = row >> 11, t = row & (SEQ - 1);
        const v4u* qp = (const v4u*)(PROJ + (size_t)row * PLD + C_QS + h * 64);
        v4u q[8];
#pragma unroll
        for (int i = 0; i < 8; ++i) q[i] = qp[i];
        float s[2]; bool valid[2];
#pragma unroll
        for (int i = 0; i < 2; ++i) { const int dist = lane + 64 * i; valid[i] = (t - dist >= 0); s[i] = -1e30f;
            if (valid[i]) { const v4u* kp = (const v4u*)(PROJ + (size_t)(row - dist) * PLD + C_KS + kvh * 64); float d = 0.f;
#pragma unroll
                for (int c = 0; c < 8; ++c) { const v4u kk = kp[c];
                    d += bflo(q[c].x) * bflo(kk.x) + bfhi(q[c].x) * bfhi(kk.x) + bflo(q[c].y) * bflo(kk.y) + bfhi(q[c].y) * bfhi(kk.y)
                       + bflo(q[c].z) * bflo(kk.z) + bfhi(q[c].z) * bfhi(kk.z) + bflo(q[c].w) * bflo(kk.w) + bfhi(q[c].w) * bfhi(kk.w); }
                s[i] = d + LOG2E * rel_bias[REL_BUCKET[dist] * 16 + h]; } }
        const float sink2 = LOG2E * sinks[h];
        const float mx = __builtin_fmaxf(wave_max(__builtin_fmaxf(s[0], s[1])), sink2);
        float p[2];
#pragma unroll
        for (int i = 0; i < 2; ++i) p[i] = valid[i] ? exp2f(s[i] - mx) : 0.f;
        const float l = wave_sum(p[0] + p[1]) + exp2f(sink2 - mx);
        float o = 0.f;
        for (int d = 0; d < 64; ++d) { const bf16* vt = VT + ((size_t)((b * 2 + kvh) * 64 + d) << 11);
            float v = 0.f;
            if (valid[0]) v += p[0] * bf2f(vt[t - lane]);
            if (valid[1]) v += p[1] * bf2f(vt[t - lane - 64]);
            v = wave_sum(v); if (lane == d) o = v; }
        const float g = bf2f(PROJ[(size_t)row * PLD + C_GSWA + h * 64 + lane]);
        Y[(size_t)row * YLD + 1024 + h * 64 + lane] = (bf16)f2bf(o / l * g);
    }
}
__device__ __forceinline__ void p2_mem_naive(Frame& F) {
    const bf16* PROJ = (const bf16*)(F.ws + WS_PROJ); const bf16* MK = (const bf16*)(F.ws + WS_MK); const bf16* MVT = (const bf16*)(F.ws + WS_MVT); bf16* Y = (bf16*)(F.ws + WS_Y);
    const int gw = F.vcu * NWAVES + F.wave, NGW = F.G * NWAVES, lane = F.lane;
    for (int task = gw; task < TOK * 4; task += NGW) {
        const int row = task >> 2, h = task & 3, b = row >> 11;
        const v4u* qp = (const v4u*)(PROJ + (size_t)row * PLD + C_QM + h * 256);
        float s[4] = {0.f, 0.f, 0.f, 0.f};
        for (int c = 0; c < 32; ++c) { const v4u qq = qp[c];
#pragma unroll
            for (int i = 0; i < 4; ++i) { const v4u kk = *((const v4u*)(MK + (size_t)(b * 256 + lane + 64 * i) * 1024 + h * 256) + c);
                s[i] += bflo(qq.x) * bflo(kk.x) + bfhi(qq.x) * bfhi(kk.x) + bflo(qq.y) * bflo(kk.y) + bfhi(qq.y) * bfhi(kk.y)
                      + bflo(qq.z) * bflo(kk.z) + bfhi(qq.z) * bfhi(kk.z) + bflo(qq.w) * bflo(kk.w) + bfhi(qq.w) * bfhi(kk.w); } }
        const float mx = wave_max(__builtin_fmaxf(__builtin_fmaxf(s[0], s[1]), __builtin_fmaxf(s[2], s[3])));
        float p[4];
#pragma unroll
        for (int i = 0; i < 4; ++i) p[i] = exp2f(s[i] - mx);
        const float l = wave_sum((p[0] + p[1]) + (p[2] + p[3]));
        float o[4] = {0.f, 0.f, 0.f, 0.f};
        for (int d = 0; d < 256; ++d) { const bf16* vt = MVT + ((size_t)((b * 4 + h) * 256 + d) << 8);
            float v = p[0] * bf2f(vt[lane]) + p[1] * bf2f(vt[lane + 64]) + p[2] * bf2f(vt[lane + 128]) + p[3] * bf2f(vt[lane + 192]);
            v = wave_sum(v);
            if (lane == (d & 63)) { if ((d >> 6) == 0) o[0] = v; else if ((d >> 6) == 1) o[1] = v; else if ((d >> 6) == 2) o[2] = v; else o[3] = v; } }
#pragma unroll
        for (int i = 0; i < 4; ++i) { const int d = lane + 64 * i; const float g = bf2f(PROJ[(size_t)row * PLD + C_GMEM + h * 256 + d]);
            Y[(size_t)row * YLD + 2048 + h * 256 + d] = (bf16)f2bf(o[i] / l * g); }
    }
}
__device__ __forceinline__ void p5_final(Frame& F) {
    const float* OUT32 = (const float*)(F.ws + WS_OUT32);
    const int gw = F.vcu * NWAVES + F.wave, NGW = F.G * NWAVES, lane = F.lane;
    for (int m = gw; m < TOK; m += NGW) {
        const GAS f32x4* orow = (const GAS f32x4*)(OUT32 + (size_t)m * DM) + lane; const GAS f32x4* xr = (const GAS f32x4*)(F.in[0] + (size_t)m * DM) + lane;
        const GAS f32x4* gr = (const GAS f32x4*)F.in[3] + lane; GAS f32x4* dst = (GAS f32x4*)(F.out + (size_t)m * DM) + lane;
        f32x4 v[8]; float s = 0.f;
#pragma unroll
        for (int j = 0; j < 8; ++j) { v[j] = orow[64 * j]; s += (v[j].x * v[j].x + v[j].y * v[j].y) + (v[j].z * v[j].z + v[j].w * v[j].w); }
        const float rstd = 1.0f / sqrtf(wave_sum(s) * (1.f / DM) + EPS);
#pragma unroll
        for (int j = 0; j < 8; ++j) dst[64 * j] = xr[64 * j] + v[j] * rstd * gr[64 * j];
    }
}

constexpr int N_PHASES = 8;
struct Args { const float* in[20]; float* out; unsigned char* ws; int ph_lo, ph_hi, use_bar, pad; };
__global__ void __launch_bounds__(NWAVES * 64, 2) hybrid_fwd(Args args) {
    extern __shared__ __attribute__((aligned(16))) unsigned char lds[];
    Frame F;
    F.lds = (LAS unsigned char*)lds;
    F.MISC = (volatile LAS unsigned*)(F.lds + MISC_OFF);
    F.tid = threadIdx.x; F.lane = F.tid & 63; F.wave = __builtin_amdgcn_readfirstlane(F.tid >> 6);
    F.G = gridDim.x; { const int bx = blockIdx.x; F.vcu = (F.G % 8 == 0) ? (bx % 8) * (F.G / 8) + bx / 8 : bx; }
#pragma unroll
    for (int i = 0; i < 20; ++i) F.in[i] = args.in[i];
    F.out = args.out; F.ws = args.ws; F.ctl = (gu32*)(args.ws + WS_CTL);
    for (int u = F.tid; u < (LDS_BYTES - LDSCTL_OFF) / 4; u += NWAVES * 64) ((LAS unsigned*)(F.lds + LDSCTL_OFF))[u] = 0u;
    __syncthreads();
    XcdBarrier bar; bar.bar = (unsigned*)(F.ctl + CW_BAR); bar.x = 0; bar.st = nullptr;
    if (args.use_bar) bar = xcd_barrier_post((unsigned*)(F.ctl + CW_BAR), F.MISC + 8);
    const int lo = args.ph_lo, hi = args.ph_hi;
#define IN(k) (lo <= (k) && (k) < hi)
#define SEAM(k) do { if (IN(k) && IN((k) + 1)) xcd_barrier(bar); } while (0)

    if (IN(0)) { p0_prologue(F); } SEAM(0);
    if (IN(1)) {
        pg8::Gemm g{(const pg8::bf16_t*)(F.ws + WS_H), (const pg8::bf16_t*)(F.ws + WS_WIN), 9216, 14592, DM};
        pg8::OrderP1 S; S.init(F.G, (int)blockIdx.x);
        pg8::EpiP1 E{(pg8::bf16_t*)(F.ws + WS_PROJ), (pg8::bf16_t*)(F.ws + WS_VT), (unsigned short*)(F.ws + WS_GATES), (pg8::bf16_t*)(F.ws + WS_MK), (pg8::bf16_t*)(F.ws + WS_MVT)};
        pg8::gemm_phase<pg8::EpiP1, pg8::OrderP1, PG8_ALIGN, PG8_SP2>(F.lds + RING_OFF, g, S, E);
    } SEAM(1);
    if (IN(2)) { p2_rglru_gates_naive(F); p2_swa_naive(F); p2_mem_naive(F); } SEAM(2);
    if (IN(3)) { p2_rglru_scan_naive(F); } SEAM(3);
    if (IN(4)) {
        pg8::Gemm g{(const pg8::bf16_t*)(F.ws + WS_Y), (const pg8::bf16_t*)(F.ws + WS_WBR), TOK, DM, YLD};
        pg8::StaticOrder S; S.init(TOK, DM, F.G, (int)blockIdx.x);
        pg8::EpiP3 E{(const unsigned short*)(F.ws + WS_GATES), (pg8::bf16_t*)(F.ws + WS_MERGED)};
        pg8::gemm_phase<pg8::EpiP3, pg8::StaticOrder, PG8_ALIGN, PG8_SP2>(F.lds + RING_OFF, g, S, E);
    } SEAM(4);
    if (IN(5)) {
        pg8::Gemm g{(const pg8::bf16_t*)(F.ws + WS_MERGED), (const pg8::bf16_t*)(F.ws + WS_WOUT), TOK, DM, DM};
        pg8::StaticOrder S; S.init(TOK, DM, F.G, (int)blockIdx.x);
        pg8::EpiF32 E{(float*)(F.ws + WS_OUT32), DM};
        pg8::gemm_phase<pg8::EpiF32, pg8::StaticOrder, PG8_ALIGN, PG8_SP2>(F.lds + RING_OFF, g, S, E);
    } SEAM(5);
    if (IN(6)) { p5_final(F); }
#undef IN
#undef SEAM
}

extern "C" void kernel_launch(void* const* d_in, const int* in_sizes, int n_in, void* d_out, int out_size, void* d_ws, size_t ws_size, hipStream_t stream) {
    static int grid = 0;
    if (grid == 0) {
        if (n_in != 20 || in_sizes[0] != TOK * DM || out_size != TOK * DM || ws_size < WS_END) { fprintf(stderr, "kernel_launch: unexpected shapes (n_in %d, in0 %d, out %d, ws %zu)\n", n_in, n_in > 0 ? in_sizes[0] : -1, out_size, ws_size); grid = -1; return; }
        int dev = 0, cus = 0, per_cu = 0;
        if (hipGetDevice(&dev) != hipSuccess || hipDeviceGetAttribute(&cus, hipDeviceAttributeMultiprocessorCount, dev) != hipSuccess) { grid = -1; return; }
        if (hipFuncSetAttribute((const void*)hybrid_fwd, hipFuncAttributeMaxDynamicSharedMemorySize, LDS_BYTES) != hipSuccess) { fprintf(stderr, "kernel_launch: hipFuncSetAttribute failed\n"); grid = -1; return; }
        if (hipOccupancyMaxActiveBlocksPerMultiprocessor(&per_cu, (const void*)hybrid_fwd, NWAVES * 64, LDS_BYTES) != hipSuccess || per_cu < 1) { fprintf(stderr, "kernel_launch: occupancy query says %d workgroups per CU\n", per_cu); (void)hipGetLastError(); grid = -1; return; }
        grid = cus;
    }
    if (grid < 0) return;
    if (hipMemsetAsync((char*)d_ws + WS_CTL, 0, CTL_ZERO_BYTES, stream) != hipSuccess) return;
    Args a{};
    for (int i = 0; i < 20; ++i) a.in[i] = (const float*)d_in[i];
    a.out = (float*)d_out; a.ws = (unsigned char*)d_ws;
#ifndef N_LAUNCH_PER_PHASE
#define N_LAUNCH_PER_PHASE 1
#endif
#if N_LAUNCH_PER_PHASE
    for (int p = 0; p < 7; ++p) { a.ph_lo = p; a.ph_hi = p + 1; a.use_bar = 0; hipLaunchKernelGGL(hybrid_fwd, dim3(grid), dim3(NWAVES * 64), LDS_BYTES, stream, a); }
#else
    a.ph_lo = 0; a.ph_hi = 7; a.use_bar = 1; hipLaunchKernelGGL(hybrid_fwd, dim3(grid), dim3(NWAVES * 64), LDS_BYTES, stream, a);
#endif
}
```

```cpp
#include <hip/hip_runtime.h>
#include <cstdio>
#include <cstdint>
namespace pg8 {
#define PG8_LAS __attribute__((address_space(3)))
typedef unsigned short bf16_t;
typedef short bf16x8 __attribute__((ext_vector_type(8)));
typedef float f32x4 __attribute__((ext_vector_type(4)));
typedef unsigned u32x4 __attribute__((ext_vector_type(4)));
constexpr int BM = 256, BK = 64, HALF = 128, HTB = HALF * BK * 2  , STAGE_BYTES = 8 * HTB, NXCD = 8, WGM = 8;

__host__ __device__ __forceinline__ int lds_byte(int r, int c) { const int st = (r >> 4) * 2 + (c >> 5), rr = r & 15, cc = c & 31, ob = rr * 64 + cc * 2; return st * 1024 + (ob ^ (((ob >> 9) & 1) << 5)); }
__host__ __device__ __forceinline__ void stage_rc(int b, int& R, int& C) { const int st = b / 1024, sb = b % 1024, swz = sb ^ (((sb >> 9) & 1) << 5); R = (st >> 1) * 16 + swz / 64; C = (st & 1) * 32 + (swz % 64) / 2; }
__host__ __device__ __forceinline__ int perm32(int rho) { const int n = rho >> 4, i = rho & 15; return 8 * (i >> 2) + 4 * n + (i & 3); }

struct Unit { int pm, pn; };
struct Gemm { const bf16_t* A; const bf16_t* Bt; int M, N, K; };


struct StaticOrder {
    int nM, nN, nwg, G, c;
    __host__ __device__ void init(int M, int N, int G_, int c_) { nM = M / BM; nN = N / BM; nwg = nM * nN; G = G_; c = c_; }
    __host__ __device__ bool next(int i, Unit& u) const {
        const long L = (long)i * G + c; if (L >= nwg) return false;
        int wgid = (int)L; { const int q = nwg / NXCD, r = nwg % NXCD, xcd = wgid % NXCD, off = wgid / NXCD; wgid = (xcd < r ? xcd * (q + 1) : r * (q + 1) + (xcd - r) * q) + off; }
        const int nig = WGM * nN, gid = wgid / nig, fm = gid * WGM, gsz = (nM - fm) < WGM ? (nM - fm) : WGM;
        u.pm = fm + ((wgid % nig) % gsz); u.pn = (wgid % nig) / gsz; return true;
    }
    __device__ __forceinline__ void a_ready(const Unit&) const {}
    __device__ __forceinline__ void done(const Unit&) const {}
};
struct OrderP1 {
    StaticOrder s; int nmain;
    __host__ __device__ void init(int G_, int c_) { s.init(8192, 12544, G_, c_); nmain = s.nwg; }
    __host__ __device__ bool next(int i, Unit& u) const {
        const long L = (long)i * s.G + s.c;
        if (L < nmain) return s.next(i, u);
        const int r = (int)(L - nmain); if (r >= 32) return false;
        u.pm = 32 + (r & 3); u.pn = 49 + (r >> 2); return true;
    }
    __device__ __forceinline__ void a_ready(const Unit&) const {}
    __device__ __forceinline__ void done(const Unit&) const {}
};

__device__ __forceinline__ unsigned cvt_pk_bf16(float lo, float hi) { unsigned r; asm volatile("v_cvt_pk_bf16_f32 %0, %1, %2" : "=v"(r) : "v"(lo), "v"(hi)); return r; }
typedef _Float16 h16x2 __attribute__((ext_vector_type(2)));
__device__ __forceinline__ unsigned pk_f16(float lo, float hi) { h16x2 v = {(_Float16)lo, (_Float16)hi}; return __builtin_bit_cast(unsigned, v); }
__device__ __forceinline__ float f16lo(unsigned w) { h16x2 v = __builtin_bit_cast(h16x2, w); return (float)v.x; }
__device__ __forceinline__ float f16hi(unsigned w) { h16x2 v = __builtin_bit_cast(h16x2, w); return (float)v.y; }
constexpr float LOG2E = 1.4426950408889634f;
__device__ __forceinline__ float sigmoid_f(float v) { return __builtin_amdgcn_rcpf(1.0f + __builtin_amdgcn_exp2f(-LOG2E * v)); }

struct EpiP1 {
    static constexpr bool PERM = true, AFTER_DRAIN = false, HAS_MID = false; static constexpr int MID0 = -1, MID1 = -1;
    bf16_t* PROJ; bf16_t* VT; unsigned short* GATES; bf16_t* MK; bf16_t* MVT;
    __device__ __forceinline__ void mid(f32x4 (&)[2][2][4][2], const Unit&, int, int, int, int, int) const {}
    __device__ __forceinline__ void operator()(const f32x4 (&acc)[2][2][4][2], const Unit& u, int wr, int wc, int fr, int fq) const {
        const int pn = u.pn;
        if (pn < 25) {
            const bool do_silu = (pn >= 4 && pn < 8) || (pn >= 13 && pn < 17) || (pn >= 21);
            const float sc = (pn >= 8 && pn < 12) ? (0.125f * LOG2E) : ((pn >= 17 && pn < 21) ? (0.0625f * LOG2E) : 1.0f);
            const int row0 = u.pm * BM + wr * 64 + fr, col0 = pn * BM + wc * 32 + 8 * fq;
#pragma unroll
            for (int ai = 0; ai < 2; ++ai)
#pragma unroll
                for (int m = 0; m < 4; ++m) { const int row = row0 + ai * HALF + m * 16; bf16_t* rowp = PROJ + (size_t)row * 6400 + col0;
#pragma unroll
                    for (int bj = 0; bj < 2; ++bj) { f32x4 v0 = acc[ai][bj][m][0], v1 = acc[ai][bj][m][1];
                        if (do_silu) {
#pragma unroll
                            for (int j = 0; j < 4; ++j) { v0[j] = v0[j] * sigmoid_f(v0[j]); v1[j] = v1[j] * sigmoid_f(v1[j]); } }
                        else { v0 = v0 * sc; v1 = v1 * sc; }
                        u32x4 w; w.x = cvt_pk_bf16(v0[0], v0[1]); w.y = cvt_pk_bf16(v0[2], v0[3]); w.z = cvt_pk_bf16(v1[0], v1[1]); w.w = cvt_pk_bf16(v1[2], v1[3]);
                        *(u32x4*)(rowp + bj * HALF) = w;
                        if (pn == 12 && bj == 1) {
                            const int b = row >> 11, t = row & 2047, cc = wc * 32 + 8 * fq;
                            bf16_t* vp = VT + ((size_t)((b * 2 + (cc >> 6)) * 64 + (cc & 63)) << 11) + t;
                            vp[0 << 11] = (bf16_t)(w.x & 0xffffu); vp[1 << 11] = (bf16_t)(w.x >> 16); vp[2 << 11] = (bf16_t)(w.y & 0xffffu); vp[3 << 11] = (bf16_t)(w.y >> 16);
                            vp[4 << 11] = (bf16_t)(w.z & 0xffffu); vp[5 << 11] = (bf16_t)(w.z >> 16); vp[6 << 11] = (bf16_t)(w.w & 0xffffu); vp[7 << 11] = (bf16_t)(w.w >> 16);
                        } } }
        } else if (pn < 49) {
            const int gi = pn - 25, br = gi >> 3, ct = gi & 7; const int tid = (wr * 4 + wc) * 64 + fq * 16 + fr;
            unsigned short* base = GATES + (size_t)((u.pm * 8 + ct) * 3 + br) * 65536 + (size_t)tid * 8;
#pragma unroll
            for (int ai = 0; ai < 2; ++ai)
#pragma unroll
                for (int m = 0; m < 4; ++m)
#pragma unroll
                    for (int bj = 0; bj < 2; ++bj) { f32x4 v0 = acc[ai][bj][m][0], v1 = acc[ai][bj][m][1];
#pragma unroll
                        for (int j = 0; j < 4; ++j) { v0[j] = __builtin_fmaxf(sigmoid_f(v0[j]), 6.2e-5f); v1[j] = __builtin_fmaxf(sigmoid_f(v1[j]), 6.2e-5f); }
                        u32x4 w; w.x = pk_f16(v0[0], v0[1]); w.y = pk_f16(v0[2], v0[3]); w.z = pk_f16(v1[0], v1[1]); w.w = pk_f16(v1[2], v1[3]);
                        *(u32x4*)(base + (size_t)((ai * 4 + m) * 2 + bj) * 4096) = w; }
        } else {
            const int pq = pn - 49; const int row0 = (u.pm - 32) * BM + wr * 64 + fr;
#pragma unroll
            for (int ai = 0; ai < 2; ++ai)
#pragma unroll
                for (int m = 0; m < 4; ++m) { const int row = row0 + ai * HALF + m * 16;
#pragma unroll
                    for (int bj = 0; bj < 2; ++bj) { const f32x4 v0 = acc[ai][bj][m][0], v1 = acc[ai][bj][m][1];
                        u32x4 w; w.x = cvt_pk_bf16(v0[0], v0[1]); w.y = cvt_pk_bf16(v0[2], v0[3]); w.z = cvt_pk_bf16(v1[0], v1[1]); w.w = cvt_pk_bf16(v1[2], v1[3]);
                        if (pq < 4) { *(u32x4*)(MK + (size_t)row * 1024 + pq * BM + bj * HALF + wc * 32 + 8 * fq) = w; }
                        else { const int b = row >> 8, mm = row & 255, d0 = bj * HALF + wc * 32 + 8 * fq;
                            bf16_t* vp = MVT + ((size_t)((b * 4 + (pq - 4)) * 256 + d0) << 8) + mm;
                            vp[0 << 8] = (bf16_t)(w.x & 0xffffu); vp[1 << 8] = (bf16_t)(w.x >> 16); vp[2 << 8] = (bf16_t)(w.y & 0xffffu); vp[3 << 8] = (bf16_t)(w.y >> 16);
                            vp[4 << 8] = (bf16_t)(w.z & 0xffffu); vp[5 << 8] = (bf16_t)(w.z >> 16); vp[6 << 8] = (bf16_t)(w.w & 0xffffu); vp[7 << 8] = (bf16_t)(w.w >> 16); } } }
        }
    }
};

struct EpiP3 {
    static constexpr bool PERM = true, AFTER_DRAIN = false, HAS_MID = true; static constexpr int MID0 = 16, MID1 = 32;
    const unsigned short* GATES; bf16_t* MERGED;
    __device__ __forceinline__ void mid(f32x4 (&acc)[2][2][4][2], const Unit& u, int t, int wr, int wc, int fr, int fq) const {
        const int br = (t == MID0) ? 0 : 1; const int tid = (wr * 4 + wc) * 64 + fq * 16 + fr;
        const unsigned short* g0 = GATES + (size_t)((u.pm * 8 + u.pn) * 3 + br) * 65536 + (size_t)tid * 8; const unsigned short* g1 = g0 + 65536;
#pragma unroll
        for (int ai = 0; ai < 2; ++ai)
#pragma unroll
            for (int m = 0; m < 4; ++m)
#pragma unroll
                for (int bj = 0; bj < 2; ++bj) { const size_t off = (size_t)((ai * 4 + m) * 2 + bj) * 4096;
                    const u32x4 a = *(const u32x4*)(g0 + off), b = *(const u32x4*)(g1 + off);
                    f32x4 r0, r1;
                    r0[0] = f16lo(a.x) * __builtin_amdgcn_rcpf(f16lo(b.x)); r0[1] = f16hi(a.x) * __builtin_amdgcn_rcpf(f16hi(b.x));
                    r0[2] = f16lo(a.y) * __builtin_amdgcn_rcpf(f16lo(b.y)); r0[3] = f16hi(a.y) * __builtin_amdgcn_rcpf(f16hi(b.y));
                    r1[0] = f16lo(a.z) * __builtin_amdgcn_rcpf(f16lo(b.z)); r1[1] = f16hi(a.z) * __builtin_amdgcn_rcpf(f16hi(b.z));
                    r1[2] = f16lo(a.w) * __builtin_amdgcn_rcpf(f16lo(b.w)); r1[3] = f16hi(a.w) * __builtin_amdgcn_rcpf(f16hi(b.w));
                    acc[ai][bj][m][0] = acc[ai][bj][m][0] * r0; acc[ai][bj][m][1] = acc[ai][bj][m][1] * r1; }
    }
    __device__ __forceinline__ void operator()(const f32x4 (&acc)[2][2][4][2], const Unit& u, int wr, int wc, int fr, int fq) const {
        const int tid = (wr * 4 + wc) * 64 + fq * 16 + fr;
        const unsigned short* g2 = GATES + (size_t)((u.pm * 8 + u.pn) * 3 + 2) * 65536 + (size_t)tid * 8;
        const int row0 = u.pm * BM + wr * 64 + fr, col0 = u.pn * BM + wc * 32 + 8 * fq;
#pragma unroll
        for (int ai = 0; ai < 2; ++ai)
#pragma unroll
            for (int m = 0; m < 4; ++m) { bf16_t* rowp = MERGED + (size_t)(row0 + ai * HALF + m * 16) * 2048 + col0;
#pragma unroll
                for (int bj = 0; bj < 2; ++bj) { const u32x4 a = *(const u32x4*)(g2 + (size_t)((ai * 4 + m) * 2 + bj) * 4096);
                    f32x4 v0 = acc[ai][bj][m][0], v1 = acc[ai][bj][m][1];
                    v0[0] *= f16lo(a.x); v0[1] *= f16hi(a.x); v0[2] *= f16lo(a.y); v0[3] *= f16hi(a.y);
                    v1[0] *= f16lo(a.z); v1[1] *= f16hi(a.z); v1[2] *= f16lo(a.w); v1[3] *= f16hi(a.w);
                    u32x4 w; w.x = cvt_pk_bf16(v0[0], v0[1]); w.y = cvt_pk_bf16(v0[2], v0[3]); w.z = cvt_pk_bf16(v1[0], v1[1]); w.w = cvt_pk_bf16(v1[2], v1[3]);
                    *(u32x4*)(rowp + bj * HALF) = w; } }
    }
};

struct EpiF32 {
    static constexpr bool PERM = false, AFTER_DRAIN = false, HAS_MID = false; static constexpr int MID0 = -1, MID1 = -1;
    float* C; int ldc;
    __device__ __forceinline__ void mid(f32x4 (&)[2][2][4][2], const Unit&, int, int, int, int, int) const {}
    __device__ __forceinline__ void operator()(const f32x4 (&acc)[2][2][4][2], const Unit& u, int wr, int wc, int fr, int fq) const {
        const int row0 = u.pm * BM + wr * 64 + fr, col0 = u.pn * BM + wc * 32 + 4 * fq;
#pragma unroll
        for (int ai = 0; ai < 2; ++ai)
#pragma unroll
            for (int m = 0; m < 4; ++m) { float* rowp = C + (size_t)(row0 + ai * HALF + m * 16) * ldc + col0;
#pragma unroll
                for (int bj = 0; bj < 2; ++bj)
#pragma unroll
                    for (int n = 0; n < 2; ++n) *(f32x4*)(rowp + bj * HALF + n * 16) = acc[ai][bj][m][n]; }
    }
};

template <class Epi, class Sched, bool ALIGN_EPI = false, bool SP2 = false>
__device__ __forceinline__ void gemm_phase(PG8_LAS unsigned char* lds, const Gemm g, const Sched& S, const Epi& E) {
    const int tid = threadIdx.x, wid = __builtin_amdgcn_readfirstlane(tid >> 6), lane = tid & 63, wr = wid >> 2, wc = wid & 3, fr = lane & 15, fq = lane >> 4;
    const int K = g.K, nt = K / BK;
    unsigned voffA[2], voffB[2];
#pragma unroll
    for (int i = 0; i < 2; ++i) { int R, C; stage_rc(tid * 16 + i * 8192, R, C); const int Rb = Epi::PERM ? ((R & ~31) + perm32(R & 31)) : R;
        voffA[i] = (unsigned)(R * K + C) * 2u; voffB[i] = (unsigned)(Rb * K + C) * 2u; }
    const size_t kstep = (size_t)(BK * 2);
    const size_t hstep = (size_t)HALF * K * 2;
    const size_t tstep = 2 * hstep;
    const unsigned ldsw = (unsigned)wid * 1024u;
    const int aoff = lds_byte(wr * 64 + fr, fq * 8), boff = lds_byte(wc * 32 + fr, fq * 8);
#define PG8_SA(b, h) (((b) * 2 + (h)) * HTB)
#define PG8_SB(b, h) ((4 + (b) * 2 + (h)) * HTB)
#define PG8_STAGE(bufoff, gbase, voff) do { _Pragma("unroll") for (int _i = 0; _i < 2; ++_i) \
        __builtin_amdgcn_global_load_lds((const unsigned*)((const char*)(gbase) + (voff)[_i]), (PG8_LAS unsigned*)(lds + (bufoff) + ldsw + _i * 8192), 16, 0, 0); } while (0)
#define PG8_LDA(dst, b, h) do { _Pragma("unroll") for (int m = 0; m < 4; ++m) _Pragma("unroll") for (int k = 0; k < 2; ++k) dst[m][k] = *(const PG8_LAS bf16x8*)(lds + PG8_SA(b, h) + aoff + m * 2048 + k * 1024); } while (0)
#define PG8_LDB(dst, b, h) do { _Pragma("unroll") for (int n = 0; n < 2; ++n) _Pragma("unroll") for (int k = 0; k < 2; ++k) dst[n][k] = *(const PG8_LAS bf16x8*)(lds + PG8_SB(b, h) + boff + n * 2048 + k * 1024); } while (0)
#define PG8_MMA(ai, bj, At, Bt) do { __builtin_amdgcn_s_setprio(1); _Pragma("unroll") for (int m = 0; m < 4; ++m) _Pragma("unroll") for (int n = 0; n < 2; ++n) _Pragma("unroll") for (int k = 0; k < 2; ++k) \
        acc[ai][bj][m][n] = __builtin_amdgcn_mfma_f32_16x16x32_bf16(Bt[n][k], At[m][k], acc[ai][bj][m][n], 0, 0, 0); __builtin_amdgcn_s_setprio(0); } while (0)
#define PG8_WAIT_V(n) asm volatile("s_waitcnt vmcnt(" #n ")" ::: "memory")
#define PG8_WAIT_L(n) asm volatile("s_waitcnt lgkmcnt(" #n ")" ::: "memory")
#define PG8_BAR __builtin_amdgcn_s_barrier()
#define PG8_SCHED __builtin_amdgcn_sched_barrier(0)
    Unit cur, nxt; int ui = 0;
    if (!S.next(0, cur)) return;
    f32x4 acc[2][2][4][2];
#pragma unroll
    for (int a = 0; a < 2; ++a)
#pragma unroll
        for (int b = 0; b < 2; ++b)
#pragma unroll
            for (int m = 0; m < 4; ++m)
#pragma unroll
                for (int n = 0; n < 2; ++n) acc[a][b][m][n] = (f32x4){0.f, 0.f, 0.f, 0.f};
    bf16x8 At[4][2], B0[2][2], B1[2][2];
    const char* cA = (const char*)g.A + (size_t)cur.pm * tstep; const char* cB = (const char*)g.Bt + (size_t)cur.pn * tstep;
    S.a_ready(cur);
    if constexpr (SP2) {
        PG8_STAGE(PG8_SB(0, 0), cB, voffB); PG8_STAGE(PG8_SB(0, 1), cB + hstep, voffB); PG8_STAGE(PG8_SA(0, 0), cA, voffA); PG8_STAGE(PG8_SA(0, 1), cA + hstep, voffA);
        if (wr == 1) PG8_BAR;
        PG8_WAIT_V(2); PG8_BAR;
        PG8_STAGE(PG8_SB(1, 0), cB + kstep, voffB); PG8_STAGE(PG8_SA(1, 0), cA + kstep, voffA); PG8_STAGE(PG8_SB(1, 1), cB + hstep + kstep, voffB);
        PG8_WAIT_V(6); PG8_BAR;
    } else {
        PG8_STAGE(PG8_SB(0, 0), cB, voffB); PG8_STAGE(PG8_SA(0, 0), cA, voffA); PG8_STAGE(PG8_SB(0, 1), cB + hstep, voffB); PG8_STAGE(PG8_SA(0, 1), cA + hstep, voffA);
        if (wr == 1) PG8_BAR;
        PG8_WAIT_V(4); PG8_BAR;
        PG8_STAGE(PG8_SB(1, 0), cB + kstep, voffB); PG8_STAGE(PG8_SA(1, 0), cA + kstep, voffA); PG8_STAGE(PG8_SB(1, 1), cB + hstep + kstep, voffB);
        PG8_WAIT_V(6); PG8_BAR;
    }
    for (;;) {
        const bool has_next = S.next(ui + 1, nxt);
        const char* nA = has_next ? (const char*)g.A + (size_t)nxt.pm * tstep : cA; const char* nB = has_next ? (const char*)g.Bt + (size_t)nxt.pn * tstep : cB;
        for (int t = 0; t < nt; t += 2) {
            const bool last = (t == nt - 2);
            if constexpr (Epi::HAS_MID) { if (t == Epi::MID0 || t == Epi::MID1) E.mid(acc, cur, t, wr, wc, fr, fq); }
            const char* a1 = cA + (size_t)(t + 1) * kstep;
            const char* a2 = last ? nA : cA + (size_t)(t + 2) * kstep; const char* b2 = last ? nB : cB + (size_t)(t + 2) * kstep;
            const char* a3 = a2 + kstep; const char* b3 = b2 + kstep;
            if (last && has_next) S.a_ready(nxt);
            if constexpr (SP2) {
            PG8_LDB(B0, 0, 0); PG8_LDB(B1, 0, 1); PG8_SCHED; PG8_LDA(At, 0, 0); PG8_STAGE(PG8_SA(1, 1), a1 + hstep, voffA);
            PG8_WAIT_V(8); PG8_WAIT_L(0); PG8_BAR; PG8_MMA(0, 0, At, B0); PG8_MMA(0, 1, At, B1); PG8_BAR; PG8_SCHED;
            PG8_LDA(At, 0, 1); PG8_STAGE(PG8_SB(0, 0), b2, voffB); PG8_STAGE(PG8_SB(0, 1), b2 + hstep, voffB); PG8_STAGE(PG8_SA(0, 0), a2, voffA);
            PG8_WAIT_V(8); PG8_WAIT_L(0); PG8_BAR; PG8_MMA(1, 0, At, B0); PG8_MMA(1, 1, At, B1); PG8_BAR; PG8_SCHED;
            PG8_LDB(B0, 1, 0); PG8_LDB(B1, 1, 1); PG8_SCHED; PG8_LDA(At, 1, 0); PG8_STAGE(PG8_SA(0, 1), a2 + hstep, voffA);
            PG8_WAIT_V(8); PG8_WAIT_L(0); PG8_BAR; PG8_MMA(0, 0, At, B0); PG8_MMA(0, 1, At, B1); PG8_BAR; PG8_SCHED;
            PG8_LDA(At, 1, 1); PG8_STAGE(PG8_SB(1, 0), b3, voffB); PG8_STAGE(PG8_SB(1, 1), b3 + hstep, voffB); PG8_STAGE(PG8_SA(1, 0), a3, voffA);
            PG8_WAIT_V(8); PG8_WAIT_L(0); PG8_BAR; PG8_MMA(1, 0, At, B0); PG8_MMA(1, 1, At, B1); PG8_BAR; PG8_SCHED;
            } else {
            PG8_LDB(B0, 0, 0); PG8_SCHED; PG8_LDA(At, 0, 0); PG8_STAGE(PG8_SA(1, 1), a1 + hstep, voffA);
            PG8_WAIT_L(8); PG8_BAR; PG8_WAIT_L(0); PG8_MMA(0, 0, At, B0); PG8_BAR; PG8_SCHED;
            PG8_LDB(B1, 0, 1); PG8_STAGE(PG8_SB(0, 0), b2, voffB);
            PG8_BAR; PG8_WAIT_L(0); PG8_MMA(0, 1, At, B1); PG8_BAR;
            PG8_LDA(At, 0, 1); PG8_STAGE(PG8_SA(0, 0), a2, voffA);
            PG8_BAR; PG8_WAIT_L(0); PG8_MMA(1, 0, At, B0); PG8_BAR; PG8_SCHED;
            PG8_STAGE(PG8_SB(0, 1), b2 + hstep, voffB);
            PG8_WAIT_V(6); PG8_BAR; PG8_MMA(1, 1, At, B1); PG8_BAR;
            PG8_LDB(B0, 1, 0); PG8_SCHED; PG8_LDA(At, 1, 0); PG8_STAGE(PG8_SA(0, 1), a2 + hstep, voffA);
            PG8_WAIT_L(8); PG8_BAR; PG8_WAIT_L(0); PG8_MMA(0, 0, At, B0); PG8_BAR; PG8_SCHED;
            PG8_LDB(B1, 1, 1); PG8_STAGE(PG8_SB(1, 0), b3, voffB);
            PG8_BAR; PG8_WAIT_L(0); PG8_MMA(0, 1, At, B1); PG8_BAR;
            PG8_LDA(At, 1, 1); PG8_STAGE(PG8_SA(1, 0), a3, voffA);
            PG8_BAR; PG8_WAIT_L(0); PG8_MMA(1, 0, At, B0); PG8_BAR; PG8_SCHED;
            PG8_STAGE(PG8_SB(1, 1), b3 + hstep, voffB);
            PG8_WAIT_V(6); PG8_BAR; PG8_MMA(1, 1, At, B1); PG8_BAR;
            }
        }
        if constexpr (ALIGN_EPI) { if (wr == 0) PG8_BAR; }
        if constexpr (!Epi::AFTER_DRAIN) { E(acc, cur, wr, wc, fr, fq); S.done(cur); }
        if (!has_next) break;
#pragma unroll
        for (int a = 0; a < 2; ++a)
#pragma unroll
            for (int b = 0; b < 2; ++b)
#pragma unroll
                for (int m = 0; m < 4; ++m)
#pragma unroll
                    for (int n = 0; n < 2; ++n) acc[a][b][m][n] = (f32x4){0.f, 0.f, 0.f, 0.f};
        cur = nxt; cA = nA; cB = nB; ++ui;
        if constexpr (ALIGN_EPI) { if (wr == 1) PG8_BAR; }
    }
    PG8_WAIT_V(0);
    if constexpr (!ALIGN_EPI) { if (wr == 0) PG8_BAR; }
    PG8_BAR;
    if constexpr (Epi::AFTER_DRAIN) { E.fused(acc, cur, wr, wc, fr, fq, lds, wid, lane); S.done(cur); }
#undef PG8_SA
#undef PG8_SB
#undef PG8_STAGE
#undef PG8_LDA
#undef PG8_LDB
#undef PG8_MMA
#undef PG8_WAIT_V
#undef PG8_WAIT_L
#undef PG8_BAR
#undef PG8_SCHED
}
}

#ifndef PG8_SP2
#define PG8_SP2 true
#endif
#ifndef PG8_ALIGN
#define PG8_ALIGN true
#endif
#define GAS __attribute__((address_space(1)))
#define LAS __attribute__((address_space(3)))
typedef unsigned short bf16;
typedef unsigned v4u __attribute__((ext_vector_type(4)));
typedef float f32x4 __attribute__((ext_vector_type(4)));
typedef short bf16x8 __attribute__((ext_vector_type(8)));
typedef GAS unsigned gu32;
typedef GAS unsigned long long gu64;
#define RLX_AGENT __ATOMIC_RELAXED, __HIP_MEMORY_SCOPE_AGENT
#define LDS_WAIT() asm volatile("s_waitcnt lgkmcnt(0)" ::: "memory")
#define VM_WAIT() asm volatile("s_waitcnt vmcnt(0)" ::: "memory")
__device__ __forceinline__ unsigned long long rt() { return __builtin_amdgcn_s_memrealtime(); }
__device__ __forceinline__ unsigned f2bf(float f) { unsigned u = __builtin_bit_cast(unsigned, f); return (u + 0x7fffu + ((u >> 16) & 1u)) >> 16; }
__device__ __forceinline__ unsigned pk2(float lo, float hi) { return f2bf(lo) | (f2bf(hi) << 16); }

#define XB_TMO      128
#define XB_XCNT(j)  (256  + 64 * (j))
#define XB_XSUB(j)  (1280 + 64 * (j))
#define XB_XGEN(j)  (2304 + 64 * (j))
#define XB_TOP      3328
#define XB_TOPGEN   3392
#define XCD_BAR_WORDS 3456
#define XB_SPIN_CAP (1u << 18)

__device__ __forceinline__ unsigned xb_ld(unsigned* p)              { return __hip_atomic_load(p, __ATOMIC_RELAXED, __HIP_MEMORY_SCOPE_AGENT); }
__device__ __forceinline__ unsigned xb_add(unsigned* p, unsigned v) { return __hip_atomic_fetch_add(p, v, __ATOMIC_RELAXED, __HIP_MEMORY_SCOPE_AGENT); }
__device__ __forceinline__ unsigned xb_xcc_id() { return (unsigned)__builtin_amdgcn_s_getreg((3 << 11) | 20) & 0xFu; }
#define XB_SPIN(cond, bar) do { unsigned _sp = 0; while (cond) { __builtin_amdgcn_s_sleep(1); \
    if ((++_sp & 255u) == 0u) { if (xb_ld(&(bar)[XB_TMO])) break; if (_sp > XB_SPIN_CAP) { atomicAdd(&(bar)[XB_TMO], 1u); break; } } } } while (0)

struct XcdBarrier {
    unsigned* bar; unsigned x;
    volatile LAS unsigned* st;
};

__device__ __forceinline__ XcdBarrier xcd_barrier_post(unsigned* bar, volatile LAS unsigned* st) {
    XcdBarrier b; b.bar = bar; b.x = xb_xcc_id(); b.st = st;
    if (threadIdx.x == 0) (void)xb_add(&bar[XB_XCNT(b.x)], 1u);
    return b;
}
__device__ __forceinline__ void xcd_barrier_complete(unsigned* bar, unsigned x, unsigned& nloc, unsigned& nx) {
    const unsigned G = gridDim.x * gridDim.y * gridDim.z;
    unsigned sum, cnt, mine, sp = 0u;
    for (;;) {
        sum = 0u; cnt = 0u; mine = 0u;
#pragma unroll
        for (unsigned j = 0; j < 16; ++j) { const unsigned c = xb_ld(&bar[XB_XCNT(j)]); sum += c; cnt += (c > 0u) ? 1u : 0u; mine = (j == x) ? c : mine; }
        if (sum == G) break;
        __builtin_amdgcn_s_sleep(1);
        if ((++sp & 255u) == 0u) { if (xb_ld(&bar[XB_TMO])) break; if (sp > XB_SPIN_CAP) { atomicAdd(&bar[XB_TMO], 1u); break; } }
    }
    nloc = mine > 0u ? mine : 1u; nx = cnt > 0u ? cnt : 1u;
}

__device__ __forceinline__ void xcd_barrier(const XcdBarrier& b) {
    asm volatile("s_waitcnt vmcnt(0)" ::: "memory");
    __syncthreads();
    if (threadIdx.x == 0) {
        unsigned* bar = b.bar;
        __builtin_amdgcn_s_waitcnt(0);
        unsigned nloc = b.st[0], nx = b.st[1];
        if (nloc == 0u) { xcd_barrier_complete(bar, b.x, nloc, nx); b.st[0] = nloc; b.st[1] = nx; }
        const unsigned old = xb_add(&bar[XB_XSUB(b.x)], 1u);
        const unsigned gen = old / nloc;
        if (old + 1u == (gen + 1u) * nloc) {
            __builtin_amdgcn_fence(__ATOMIC_RELEASE, "agent");
            asm volatile("s_waitcnt vmcnt(0)" ::: "memory");
            const unsigned og = xb_add(&bar[XB_TOP], 1u);
            const unsigned tg = og / nx;
            if (og + 1u == (tg + 1u) * nx) xb_add(&bar[XB_TOPGEN], 1u);
            else XB_SPIN(xb_ld(&bar[XB_TOPGEN]) == tg, bar);
            __builtin_amdgcn_fence(__ATOMIC_ACQUIRE, "agent");
            xb_add(&bar[XB_XGEN(b.x)], 1u);
            asm volatile("s_waitcnt vmcnt(0)" ::: "memory");
        } else {
            XB_SPIN(xb_ld(&bar[XB_XGEN(b.x)]) == gen, bar);
            __builtin_amdgcn_fence(__ATOMIC_ACQUIRE, "agent");
            asm volatile("s_waitcnt vmcnt(0)" ::: "memory");
        }
    }
    __syncthreads();
}


constexpr int NWAVES = 8;
constexpr int BATCH = 4, SEQ = 2048, DM = 2048, TOK = BATCH * SEQ, MEML = 256, MROWS = BATCH * MEML;
constexpr int D_RNN = 1024, D_IN = 12544, PLD = 6400, YLD = 3072;
constexpr int C_XR = 0, C_GRG = 1024, C_QS = 2048, C_KS = 3072, C_VS = 3200, C_GSWA = 3328, C_QM = 4352, C_GMEM = 5376;
constexpr float EPS = 1e-6f;
constexpr float LOG2E = 1.4426950408889634f;
__device__ const unsigned char REL_BUCKET[128] = {0, 1, 2, 3, 4, 5, 6, 7, 8, 9, 10, 11, 12, 13, 14, 15, 16, 16, 16, 17, 17, 18, 18, 18, 19, 19, 19, 20, 20, 20, 20, 21, 21, 21, 21, 22, 22, 22, 22, 22, 23, 23, 23, 23, 23, 23, 24, 24, 24, 24, 24, 24, 25, 25, 25, 25, 25, 25, 25, 26, 26, 26, 26, 26, 26, 26, 26, 27, 27, 27, 27, 27, 27, 27, 27, 27, 27, 28, 28, 28, 28, 28, 28, 28, 28, 28, 28, 29, 29, 29, 29, 29, 29, 29, 29, 29, 29, 29, 29, 30, 30, 30, 30, 30, 30, 30, 30, 30, 30, 30, 30, 30, 30, 31, 31, 31, 31, 31, 31, 31, 31, 31, 31, 31, 31, 31, 31, 31};

constexpr size_t MiB = 1u << 20;
constexpr size_t WS_CTL = 0, CTL_ZERO_BYTES = 1 * MiB;
constexpr size_t WS_WIN = 2 * MiB;
constexpr size_t WS_WMKV = 51 * MiB;
constexpr size_t WS_WBR = 59 * MiB;
constexpr size_t WS_WOUT = 71 * MiB;
constexpr size_t WS_H = 80 * MiB;
constexpr size_t WS_MEMN = 112 * MiB;
constexpr size_t WS_PROJ = 116 * MiB;
constexpr size_t WS_VT = 216 * MiB;
constexpr size_t WS_MK = 218 * MiB;
constexpr size_t WS_MVT = 220 * MiB;
constexpr size_t WS_GATES = 222 * MiB;
constexpr size_t WS_Y = 318 * MiB;
constexpr size_t WS_MERGED = WS_H;
constexpr size_t WS_OUT32 = WS_PROJ;
constexpr size_t WS_END = 366 * MiB;
static_assert(WS_WIN + (size_t)12544 * 2048 * 2 == WS_WMKV && WS_H + (size_t)TOK * DM * 2 == WS_MEMN && WS_PROJ + (size_t)TOK * PLD * 2 == WS_VT && WS_GATES + (size_t)768 * 131072 == WS_Y && WS_Y + (size_t)TOK * YLD * 2 == WS_END, "d_ws map");
constexpr int CW_TMO = 0, CW_CODE = 1;
constexpr int CW_BAR = 4096;

constexpr int RING_OFF = 0, RING_BYTES = 131072;
constexpr int LDSCTL_OFF = RING_BYTES, MISC_OFF = LDSCTL_OFF + 320;
constexpr int LDS_BYTES = 147456;
static_assert(MISC_OFF + 128 <= LDS_BYTES, "LDS map");


struct Frame {
    LAS unsigned char* lds;
    volatile LAS unsigned* MISC;
    gu32* ctl;
    int tid, lane, wave;
    int vcu, G;
    const float* in[20]; float* out; unsigned char* ws;
};
__device__ __forceinline__ float wave_sum(float v) {
#pragma unroll
    for (int o = 1; o < 64; o <<= 1) v += __shfl_xor(v, o);
    return v;
}
__device__ __forceinline__ float wave_max(float v) {
#pragma unroll
    for (int o = 1; o < 64; o <<= 1) v = __builtin_fmaxf(v, __shfl_xor(v, o));
    return v;
}
__device__ __forceinline__ float bf2f(bf16 u) { return __uint_as_float((unsigned)u << 16); }
__device__ __forceinline__ float bflo(unsigned w) { return __uint_as_float(w << 16); }
__device__ __forceinline__ float bfhi(unsigned w) { return __uint_as_float(w & 0xffff0000u); }

__device__ __forceinline__ void p0_transpose_item(const float* W, int N, bf16* WT, int ldt, int col_off, LAS float* scr, int item, int lane) {
    const int nblk = N / 32, kb = item / nblk, nb = item % nblk, k0 = 64 * kb, n0 = 32 * nb;
#pragma unroll 8
    for (int i = 0; i < 32; ++i) { const int kk = 2 * i + (lane >> 5); scr[kk * 33 + (lane & 31)] = W[(size_t)(k0 + kk) * N + n0 + (lane & 31)]; }
    LDS_WAIT(); asm volatile("" ::: "memory");
    const int c = lane & 7;
#pragma unroll
    for (int j = 0; j < 4; ++j) { const int n = (lane >> 3) + 8 * j; const LAS float* s = scr + (8 * c) * 33 + n;
        v4u o; o.x = pk2(s[0 * 33], s[1 * 33]); o.y = pk2(s[2 * 33], s[3 * 33]); o.z = pk2(s[4 * 33], s[5 * 33]); o.w = pk2(s[6 * 33], s[7 * 33]);
        *(GAS v4u*)(WT + (size_t)(n0 + n) * ldt + col_off + k0 + 8 * c) = o; }
    LDS_WAIT(); asm volatile("" ::: "memory");
}
__device__ __forceinline__ void rms_row_to_bf16(int lane, const float* xrow, const float* g, bf16* orow) {
    const GAS f32x4* xr = (const GAS f32x4*)xrow + lane; const GAS f32x4* gr = (const GAS f32x4*)g + lane;
    f32x4 v[8]; float s = 0.f;
#pragma unroll
    for (int j = 0; j < 8; ++j) { v[j] = xr[64 * j]; s += (v[j].x * v[j].x + v[j].y * v[j].y) + (v[j].z * v[j].z + v[j].w * v[j].w); }
    const float rstd = 1.0f / sqrtf(wave_sum(s) * (1.f / DM) + EPS);
    GAS unsigned long long* o8 = (GAS unsigned long long*)orow + lane;
#pragma unroll
    for (int j = 0; j < 8; ++j) { const f32x4 gg = gr[64 * j];
        o8[64 * j] = (unsigned long long)pk2(v[j].x * rstd * gg.x, v[j].y * rstd * gg.y) | ((unsigned long long)pk2(v[j].z * rstd * gg.z, v[j].w * rstd * gg.w) << 32); }
}
__device__ __forceinline__ void p0_prologue(Frame& F) {
    LAS float* scr = (LAS float*)(F.lds + RING_OFF + F.wave * 16384);
    const int gw = F.vcu * NWAVES + F.wave, NGW = F.G * NWAVES;
    constexpr int I_IN = (DM / 64) * (D_IN / 32), I_MKV = (DM / 64) * (2048 / 32), I_BR = (1024 / 64) * (DM / 32), I_OUT = (DM / 64) * (DM / 32);
    constexpr int NITEMS = I_IN + I_MKV + 3 * I_BR + I_OUT;
    bf16* WinT = (bf16*)(F.ws + WS_WIN); bf16* WmkvT = (bf16*)(F.ws + WS_WMKV); bf16* WbrT = (bf16*)(F.ws + WS_WBR); bf16* WoutT = (bf16*)(F.ws + WS_WOUT);
    for (int it = gw; it < NITEMS; it += NGW) {
        int r = it;
        if (r < I_IN) { p0_transpose_item(F.in[5], D_IN, WinT, DM, 0, scr, r, F.lane); continue; } r -= I_IN;
        if (r < I_MKV) { p0_transpose_item(F.in[15], 2048, WmkvT, DM, 0, scr, r, F.lane); continue; } r -= I_MKV;
        if (r < I_BR) { p0_transpose_item(F.in[16], DM, WbrT, YLD, 0, scr, r, F.lane); continue; } r -= I_BR;
        if (r < I_BR) { p0_transpose_item(F.in[17], DM, WbrT, YLD, 1024, scr, r, F.lane); continue; } r -= I_BR;
        if (r < I_BR) { p0_transpose_item(F.in[18], DM, WbrT, YLD, 2048, scr, r, F.lane); continue; } r -= I_BR;
        p0_transpose_item(F.in[19], DM, WoutT, DM, 0, scr, r, F.lane);
    }
    bf16* H = (bf16*)(F.ws + WS_H); bf16* MEMN = (bf16*)(F.ws + WS_MEMN);
    for (int m = gw; m < TOK; m += NGW) rms_row_to_bf16(F.lane, F.in[0] + (size_t)m * DM, F.in[2], H + (size_t)m * DM);
    for (int m = gw; m < MROWS; m += NGW) rms_row_to_bf16(F.lane, F.in[1] + (size_t)m * DM, F.in[4], MEMN + (size_t)m * DM);
}

__device__ __forceinline__ void p2_rglru_gates_naive(Frame& F) {
    const bf16* PROJ = (const bf16*)(F.ws + WS_PROJ); float* AB = F.out;
    const float* conv_w = F.in[6]; const float* conv_b = F.in[7]; const float* w_a = F.in[8]; const float* b_a = F.in[9]; const float* w_x = F.in[10]; const float* b_x = F.in[11]; const float* lam = F.in[12];
    LAS float* cb = (LAS float*)(F.lds) + F.wave * 128;
    const int gw = F.vcu * NWAVES + F.wave, NGW = F.G * NWAVES, lane = F.lane;
    for (int task = gw; task < TOK * 8; task += NGW) {
        const int row = task >> 3, n = task & 7, t = row & (SEQ - 1);
        float cv[2];
#pragma unroll
        for (int q = 0; q < 2; ++q) { const int c = n * 128 + lane + 64 * q; float s = conv_b[c];
#pragma unroll
            for (int k = 0; k < 4; ++k) if (t - k >= 0) s += conv_w[k * 1024 + c] * bf2f(PROJ[(size_t)(row - k) * PLD + C_XR + c]);
            cv[q] = s; cb[lane + 64 * q] = s; }
        LDS_WAIT(); asm volatile("" ::: "memory");
        float ga[2], gx[2];
#pragma unroll
        for (int q = 0; q < 2; ++q) { const int c = n * 128 + lane + 64 * q; ga[q] = b_a[c]; gx[q] = b_x[c]; }
        for (int i = 0; i < 128; ++i) { const float x = cb[i];
#pragma unroll
            for (int q = 0; q < 2; ++q) { const int j = lane + 64 * q; ga[q] += x * w_a[(size_t)(n * 128 + i) * 128 + j]; gx[q] += x * w_x[(size_t)(n * 128 + i) * 128 + j]; } }
#pragma unroll
        for (int q = 0; q < 2; ++q) { const int c = n * 128 + lane + 64 * q;
            const float r = 1.0f / (1.0f + expf(-ga[q])), ii = 1.0f / (1.0f + expf(-gx[q]));
            const float sp = log1pf(expf(-lam[c]));
            const float log_a = -8.0f * r * sp, a = expf(log_a);
            const float mult = (t == 0) ? 1.0f : sqrtf(-expm1f(2.0f * log_a));
            const float bb = mult * ii * cv[q];
            *(float2*)(AB + ((size_t)row * 1024 + c) * 2) = make_float2(a, bb); }
        LDS_WAIT(); asm volatile("" ::: "memory");
    }
}
__device__ __forceinline__ void p2_rglru_scan_naive(Frame& F) {
    const bf16* PROJ = (const bf16*)(F.ws + WS_PROJ); const float* AB = F.out; bf16* Y = (bf16*)(F.ws + WS_Y);
    const int gid = F.vcu * (NWAVES * 64) + F.tid;
    if (gid < BATCH * 1024) {
        const int b = gid >> 10, c = gid & 1023; float h = 0.f;
#pragma unroll 8
        for (int t = 0; t < SEQ; ++t) { const size_t row = (size_t)b * SEQ + t; const float2 ab = *(const float2*)(AB + (row * 1024 + c) * 2);
            h = ab.x * h + ab.y; if (t == 0) h = ab.y;
            Y[row * YLD + c] = (bf16)f2bf(h * bf2f(PROJ[row * PLD + C_GRG + c])); }
    }
}
__device__ __forceinline__ void p2_swa_naive(Frame& F) {
    const bf16* PROJ = (const bf16*)(F.ws + WS_PROJ); const bf16* VT = (const bf16*)(F.ws + WS_VT); bf16* Y = (bf16*)(F.ws + WS_Y);
    const float* sinks = F.in[13]; const float* rel_bias = F.in[14];
    const int gw = F.vcu * NWAVES + F.wave, NGW = F.G * NWAVES, lane = F.lane;
    for (int task = gw; task < TOK * 16; task += NGW) {
        const int row = task >> 4, h = task & 15, kvh = h >> 3, b = row >> 11, t = row & (SEQ - 1);
        const v4u* qp = (const v4u*)(PROJ + (size_t)row * PLD + C_QS + h * 64);
        v4u q[8];
#pragma unroll
        for (int i = 0; i < 8; ++i) q[i] = qp[i];
        float s[2]; bool valid[2];
#pragma unroll
        for (int i = 0; i < 2; ++i) { const int dist = lane + 64 * i; valid[i] = (t - dist >= 0); s[i] = -1e30f;
            if (valid[i]) { const v4u* kp = (const v4u*)(PROJ + (size_t)(row - dist) * PLD + C_KS + kvh * 64); float d = 0.f;
#pragma unroll
                for (int c = 0; c < 8; ++c) { const v4u kk = kp[c];
                    d += bflo(q[c].x) * bflo(kk.x) + bfhi(q[c].x) * bfhi(kk.x) + bflo(q[c].y) * bflo(kk.y) + bfhi(q[c].y) * bfhi(kk.y)
                       + bflo(q[c].z) * bflo(kk.z) + bfhi(q[c].z) * bfhi(kk.z) + bflo(q[c].w) * bflo(kk.w) + bfhi(q[c].w) * bfhi(kk.w); }
                s[i] = d + LOG2E * rel_bias[REL_BUCKET[dist] * 16 + h]; } }
        const float sink2 = LOG2E * sinks[h];
        const float mx = __builtin_fmaxf(wave_max(__builtin_fmaxf(s[0], s[1])), sink2);
        float p[2];
#pragma unroll
        for (int i = 0; i < 2; ++i) p[i] = valid[i] ? exp2f(s[i] - mx) : 0.f;
        const float l = wave_sum(p[0] + p[1]) + exp2f(sink2 - mx);
        float o = 0.f;
        for (int d = 0; d < 64; ++d) { const bf16* vt = VT + ((size_t)((b * 2 + kvh) * 64 + d) << 11);
            float v = 0.f;
            if (valid[0]) v += p[0] * bf2f(vt[t - lane]);
            if (valid[1]) v += p[1] * bf2f(vt[t - lane - 64]);
            v = wave_sum(v); if (lane == d) o = v; }
        const float g = bf2f(PROJ[(size_t)row * PLD + C_GSWA + h * 64 + lane]);
        Y[(size_t)row * YLD + 1024 + h * 64 + lane] = (bf16)f2bf(o / l * g);
    }
}
__device__ __forceinline__ void p2_mem_naive(Frame& F) {
    const bf16* PROJ = (const bf16*)(F.ws + WS_PROJ); const bf16* MK = (const bf16*)(F.ws + WS_MK); const bf16* MVT = (const bf16*)(F.ws + WS_MVT); bf16* Y = (bf16*)(F.ws + WS_Y);
    const int gw = F.vcu * NWAVES + F.wave, NGW = F.G * NWAVES, lane = F.lane;
    for (int task = gw; task < TOK * 4; task += NGW) {
        const int row = task >> 2, h = task & 3, b = row >> 11;
        const v4u* qp = (const v4u*)(PROJ + (size_t)row * PLD + C_QM + h * 256);
        float s[4] = {0.f, 0.f, 0.f, 0.f};
        for (int c = 0; c < 32; ++c) { const v4u qq = qp[c];
#pragma unroll
            for (int i = 0; i < 4; ++i) { const v4u kk = *((const v4u*)(MK + (size_t)(b * 256 + lane + 64 * i) * 1024 + h * 256) + c);
                s[i] += bflo(qq.x) * bflo(kk.x) + bfhi(qq.x) * bfhi(kk.x) + bflo(qq.y) * bflo(kk.y) + bfhi(qq.y) * bfhi(kk.y)
                      + bflo(qq.z) * bflo(kk.z) + bfhi(qq.z) * bfhi(kk.z) + bflo(qq.w) * bflo(kk.w) + bfhi(qq.w) * bfhi(kk.w); } }
        const float mx = wave_max(__builtin_fmaxf(__builtin_fmaxf(s[0], s[1]), __builtin_fmaxf(s[2], s[3])));
        float p[4];
#pragma unroll
        for (int i = 0; i < 4; ++i) p[i] = exp2f(s[i] - mx);
        const float l = wave_sum((p[0] + p[1]) + (p[2] + p[3]));
        float o[4] = {0.f, 0.f, 0.f, 0.f};
        for (int d = 0; d < 256; ++d) { const bf16* vt = MVT + ((size_t)((b * 4 + h) * 256 + d) << 8);
            float v = p[0] * bf2f(vt[lane]) + p[1] * bf2f(vt[lane + 64]) + p[2] * bf2f(vt[lane + 128]) + p[3] * bf2f(vt[lane + 192]);
            v = wave_sum(v);
            if (lane == (d & 63)) { if ((d >> 6) == 0) o[0] = v; else if ((d >> 6) == 1) o[1] = v; else if ((d >> 6) == 2) o[2] = v; else o[3] = v; } }
#pragma unroll
        for (int i = 0; i < 4; ++i) { const int d = lane + 64 * i; const float g = bf2f(PROJ[(size_t)row * PLD + C_GMEM + h * 256 + d]);
            Y[(size_t)row * YLD + 2048 + h * 256 + d] = (bf16)f2bf(o[i] / l * g); }
    }
}
__device__ __forceinline__ void p5_final(Frame& F) {
    const float* OUT32 = (const float*)(F.ws + WS_OUT32);
    const int gw = F.vcu * NWAVES + F.wave, NGW = F.G * NWAVES, lane = F.lane;
    for (int m = gw; m < TOK; m += NGW) {
        const GAS f32x4* orow = (const GAS f32x4*)(OUT32 + (size_t)m * DM) + lane; const GAS f32x4* xr = (const GAS f32x4*)(F.in[0] + (size_t)m * DM) + lane;
        const GAS f32x4* gr = (const GAS f32x4*)F.in[3] + lane; GAS f32x4* dst = (GAS f32x4*)(F.out + (size_t)m * DM) + lane;
        f32x4 v[8]; float s = 0.f;
#pragma unroll
        for (int j = 0; j < 8; ++j) { v[j] = orow[64 * j]; s += (v[j].x * v[j].x + v[j].y * v[j].y) + (v[j].z * v[j].z + v[j].w * v[j].w); }
        const float rstd = 1.0f / sqrtf(wave_sum(s) * (1.f / DM) + EPS);
#pragma unroll
        for (int j = 0; j < 8; ++j) dst[64 * j] = xr[64 * j] + v[j] * rstd * gr[64 * j];
    }
}

constexpr int N_PHASES = 8;
struct Args { const float* in[20]; float* out; unsigned char* ws; int ph_lo, ph_hi, use_bar, pad; };
__global__ void __launch_bounds__(NWAVES * 64, 2) hybrid_fwd(Args args) {
    extern __shared__ __attribute__((aligned(16))) unsigned char lds[];
    Frame F;
    F.lds = (LAS unsigned char*)lds;
    F.MISC = (volatile LAS unsigned*)(F.lds + MISC_OFF);
    F.tid = threadIdx.x; F.lane = F.tid & 63; F.wave = __builtin_amdgcn_readfirstlane(F.tid >> 6);
    F.G = gridDim.x; { const int bx = blockIdx.x; F.vcu = (F.G % 8 == 0) ? (bx % 8) * (F.G / 8) + bx / 8 : bx; }
#pragma unroll
    for (int i = 0; i < 20; ++i) F.in[i] = args.in[i];
    F.out = args.out; F.ws = args.ws; F.ctl = (gu32*)(args.ws + WS_CTL);
    for (int u = F.tid; u < (LDS_BYTES - LDSCTL_OFF) / 4; u += NWAVES * 64) ((LAS unsigned*)(F.lds + LDSCTL_OFF))[u] = 0u;
    __syncthreads();
    XcdBarrier bar; bar.bar = (unsigned*)(F.ctl + CW_BAR); bar.x = 0; bar.st = nullptr;
    if (args.use_bar) bar = xcd_barrier_post((unsigned*)(F.ctl + CW_BAR), F.MISC + 8);
    const int lo = args.ph_lo, hi = args.ph_hi;
#define IN(k) (lo <= (k) && (k) < hi)
#define SEAM(k) do { if (IN(k) && IN((k) + 1)) xcd_barrier(bar); } while (0)

    if (IN(0)) { p0_prologue(F); } SEAM(0);
    if (IN(1)) {
        pg8::Gemm g{(const pg8::bf16_t*)(F.ws + WS_H), (const pg8::bf16_t*)(F.ws + WS_WIN), 9216, 14592, DM};
        pg8::OrderP1 S; S.init(F.G, (int)blockIdx.x);
        pg8::EpiP1 E{(pg8::bf16_t*)(F.ws + WS_PROJ), (pg8::bf16_t*)(F.ws + WS_VT), (unsigned short*)(F.ws + WS_GATES), (pg8::bf16_t*)(F.ws + WS_MK), (pg8::bf16_t*)(F.ws + WS_MVT)};
        pg8::gemm_phase<pg8::EpiP1, pg8::OrderP1, PG8_ALIGN, PG8_SP2>(F.lds + RING_OFF, g, S, E);
    } SEAM(1);
    if (IN(2)) { p2_rglru_gates_naive(F); p2_swa_naive(F); p2_mem_naive(F); } SEAM(2);
    if (IN(3)) { p2_rglru_scan_naive(F); } SEAM(3);
    if (IN(4)) {
        pg8::Gemm g{(const pg8::bf16_t*)(F.ws + WS_Y), (const pg8::bf16_t*)(F.ws + WS_WBR), TOK, DM, YLD};
        pg8::StaticOrder S; S.init(TOK, DM, F.G, (int)blockIdx.x);
        pg8::EpiP3 E{(const unsigned short*)(F.ws + WS_GATES), (pg8::bf16_t*)(F.ws + WS_MERGED)};
        pg8::gemm_phase<pg8::EpiP3, pg8::StaticOrder, PG8_ALIGN, PG8_SP2>(F.lds + RING_OFF, g, S, E);
    } SEAM(4);
    if (IN(5)) {
        pg8::Gemm g{(const pg8::bf16_t*)(F.ws + WS_MERGED), (const pg8::bf16_t*)(F.ws + WS_WOUT), TOK, DM, DM};
        pg8::StaticOrder S; S.init(TOK, DM, F.G, (int)blockIdx.x);
        pg8::EpiF32 E{(float*)(F.ws + WS_OUT32), DM};
        pg8::gemm_phase<pg8::EpiF32, pg8::StaticOrder, PG8_ALIGN, PG8_SP2>(F.lds + RING_OFF, g, S, E);
    } SEAM(5);
    if (IN(6)) { p5_final(F); }
#undef IN
#undef SEAM
}

extern "C" void kernel_launch(void* const* d_in, const int* in_sizes, int n_in, void* d_out, int out_size, void* d_ws, size_t ws_size, hipStream_t stream) {
    static int grid = 0;
    if (grid == 0) {
        if (n_in != 20 || in_sizes[0] != TOK * DM || out_size != TOK * DM || ws_size < WS_END) { fprintf(stderr, "kernel_launch: unexpected shapes (n_in %d, in0 %d, out %d, ws %zu)\n", n_in, n_in > 0 ? in_sizes[0] : -1, out_size, ws_size); grid = -1; return; }
        int dev = 0, cus = 0, per_cu = 0;
        if (hipGetDevice(&dev) != hipSuccess || hipDeviceGetAttribute(&cus, hipDeviceAttributeMultiprocessorCount, dev) != hipSuccess) { grid = -1; return; }
        if (hipFuncSetAttribute((const void*)hybrid_fwd, hipFuncAttributeMaxDynamicSharedMemorySize, LDS_BYTES) != hipSuccess) { fprintf(stderr, "kernel_launch: hipFuncSetAttribute failed\n"); grid = -1; return; }
        if (hipOccupancyMaxActiveBlocksPerMultiprocessor(&per_cu, (const void*)hybrid_fwd, NWAVES * 64, LDS_BYTES) != hipSuccess || per_cu < 1) { fprintf(stderr, "kernel_launch: occupancy query says %d workgroups per CU\n", per_cu); (void)hipGetLastError(); grid = -1; return; }
        grid = cus;
    }
    if (grid < 0) return;
    if (hipMemsetAsync((char*)d_ws + WS_CTL, 0, CTL_ZERO_BYTES, stream) != hipSuccess) return;
    Args a{};
    for (int i = 0; i < 20; ++i) a.in[i] = (const float*)d_in[i];
    a.out = (float*)d_out; a.ws = (unsigned char*)d_ws;
#ifndef N_LAUNCH_PER_PHASE
#define N_LAUNCH_PER_PHASE 0
#endif
#if N_LAUNCH_PER_PHASE
    for (int p = 0; p < 7; ++p) { a.ph_lo = p; a.ph_hi = p + 1; a.use_bar = 0; hipLaunchKernelGGL(hybrid_fwd, dim3(grid), dim3(NWAVES * 64), LDS_BYTES, stream, a); }
#else
    a.ph_lo = 0; a.ph_hi = 7; a.use_bar = 1; hipLaunchKernelGGL(hybrid_fwd, dim3(grid), dim3(NWAVES * 64), LDS_BYTES, stream, a);
#endif
}
```

```cpp
#include <hip/hip_runtime.h>
#include <cstdio>
#include <cstdint>
namespace pg8 {
#define PG8_LAS __attribute__((address_space(3)))
typedef unsigned short bf16_t;
typedef short bf16x8 __attribute__((ext_vector_type(8)));
typedef float f32x4 __attribute__((ext_vector_type(4)));
typedef unsigned u32x4 __attribute__((ext_vector_type(4)));
constexpr int BM = 256, BK = 64, HALF = 128, HTB = HALF * BK * 2  , STAGE_BYTES = 8 * HTB, NXCD = 8, WGM = 8;

__host__ __device__ __forceinline__ int lds_byte(int r, int c) { const int st = (r >> 4) * 2 + (c >> 5), rr = r & 15, cc = c & 31, ob = rr * 64 + cc * 2; return st * 1024 + (ob ^ (((ob >> 9) & 1) << 5)); }
__host__ __device__ __forceinline__ void stage_rc(int b, int& R, int& C) { const int st = b / 1024, sb = b % 1024, swz = sb ^ (((sb >> 9) & 1) << 5); R = (st >> 1) * 16 + swz / 64; C = (st & 1) * 32 + (swz % 64) / 2; }
__host__ __device__ __forceinline__ int perm32(int rho) { const int n = rho >> 4, i = rho & 15; return 8 * (i >> 2) + 4 * n + (i & 3); }

struct Unit { int pm, pn; };
struct Gemm { const bf16_t* A; const bf16_t* Bt; int M, N, K; };


struct StaticOrder {
    int nM, nN, nwg, G, c;
    __host__ __device__ void init(int M, int N, int G_, int c_) { nM = M / BM; nN = N / BM; nwg = nM * nN; G = G_; c = c_; }
    __host__ __device__ bool next(int i, Unit& u) const {
        const long L = (long)i * G + c; if (L >= nwg) return false;
        int wgid = (int)L; { const int q = nwg / NXCD, r = nwg % NXCD, xcd = wgid % NXCD, off = wgid / NXCD; wgid = (xcd < r ? xcd * (q + 1) : r * (q + 1) + (xcd - r) * q) + off; }
        const int nig = WGM * nN, gid = wgid / nig, fm = gid * WGM, gsz = (nM - fm) < WGM ? (nM - fm) : WGM;
        u.pm = fm + ((wgid % nig) % gsz); u.pn = (wgid % nig) / gsz; return true;
    }
    __device__ __forceinline__ void a_ready(const Unit&) const {}
    __device__ __forceinline__ void done(const Unit&) const {}
};
struct OrderP1 {
    StaticOrder s; int nmain;
    __host__ __device__ void init(int G_, int c_) { s.init(8192, 12544, G_, c_); nmain = s.nwg; }
    __host__ __device__ bool next(int i, Unit& u) const {
        const long L = (long)i * s.G + s.c;
        if (L < nmain) return s.next(i, u);
        const int r = (int)(L - nmain); if (r >= 32) return false;
        u.pm = 32 + (r & 3); u.pn = 49 + (r >> 2); return true;
    }
    __device__ __forceinline__ void a_ready(const Unit&) const {}
    __device__ __forceinline__ void done(const Unit&) const {}
};

__device__ __forceinline__ unsigned cvt_pk_bf16(float lo, float hi) { unsigned r; asm volatile("v_cvt_pk_bf16_f32 %0, %1, %2" : "=v"(r) : "v"(lo), "v"(hi)); return r; }
typedef _Float16 h16x2 __attribute__((ext_vector_type(2)));
__device__ __forceinline__ unsigned pk_f16(float lo, float hi) { h16x2 v = {(_Float16)lo, (_Float16)hi}; return __builtin_bit_cast(unsigned, v); }
__device__ __forceinline__ float f16lo(unsigned w) { h16x2 v = __builtin_bit_cast(h16x2, w); return (float)v.x; }
__device__ __forceinline__ float f16hi(unsigned w) { h16x2 v = __builtin_bit_cast(h16x2, w); return (float)v.y; }
constexpr float LOG2E = 1.4426950408889634f;
__device__ __forceinline__ float sigmoid_f(float v) { return __builtin_amdgcn_rcpf(1.0f + __builtin_amdgcn_exp2f(-LOG2E * v)); }

struct EpiP1 {
    static constexpr bool PERM = true, AFTER_DRAIN = false, HAS_MID = false; static constexpr int MID0 = -1, MID1 = -1;
    bf16_t* PROJ; bf16_t* VT; unsigned short* GATES; bf16_t* MK; bf16_t* MVT;
    __device__ __forceinline__ void mid(f32x4 (&)[2][2][4][2], const Unit&, int, int, int, int, int) const {}
    __device__ __forceinline__ void operator()(const f32x4 (&acc)[2][2][4][2], const Unit& u, int wr, int wc, int fr, int fq) const {
        const int pn = u.pn;
        if (pn < 25) {
            const bool do_silu = (pn >= 4 && pn < 8) || (pn >= 13 && pn < 17) || (pn >= 21);
            const float sc = (pn >= 8 && pn < 12) ? (0.125f * LOG2E) : ((pn >= 17 && pn < 21) ? (0.0625f * LOG2E) : 1.0f);
            const int row0 = u.pm * BM + wr * 64 + fr, col0 = pn * BM + wc * 32 + 8 * fq;
#pragma unroll
            for (int ai = 0; ai < 2; ++ai)
#pragma unroll
                for (int m = 0; m < 4; ++m) { const int row = row0 + ai * HALF + m * 16; bf16_t* rowp = PROJ + (size_t)row * 6400 + col0;
#pragma unroll
                    for (int bj = 0; bj < 2; ++bj) { f32x4 v0 = acc[ai][bj][m][0], v1 = acc[ai][bj][m][1];
                        if (do_silu) {
#pragma unroll
                            for (int j = 0; j < 4; ++j) { v0[j] = v0[j] * sigmoid_f(v0[j]); v1[j] = v1[j] * sigmoid_f(v1[j]); } }
                        else { v0 = v0 * sc; v1 = v1 * sc; }
                        u32x4 w; w.x = cvt_pk_bf16(v0[0], v0[1]); w.y = cvt_pk_bf16(v0[2], v0[3]); w.z = cvt_pk_bf16(v1[0], v1[1]); w.w = cvt_pk_bf16(v1[2], v1[3]);
                        *(u32x4*)(rowp + bj * HALF) = w;
                        if (pn == 12 && bj == 1) {
                            const int b = row >> 11, t = row & 2047, cc = wc * 32 + 8 * fq;
                            bf16_t* vp = VT + ((size_t)((b * 2 + (cc >> 6)) * 64 + (cc & 63)) << 11) + t;
                            vp[0 << 11] = (bf16_t)(w.x & 0xffffu); vp[1 << 11] = (bf16_t)(w.x >> 16); vp[2 << 11] = (bf16_t)(w.y & 0xffffu); vp[3 << 11] = (bf16_t)(w.y >> 16);
                            vp[4 << 11] = (bf16_t)(w.z & 0xffffu); vp[5 << 11] = (bf16_t)(w.z >> 16); vp[6 << 11] = (bf16_t)(w.w & 0xffffu); vp[7 << 11] = (bf16_t)(w.w >> 16);
                        } } }
        } else if (pn < 49) {
            const int gi = pn - 25, br = gi >> 3, ct = gi & 7; const int tid = (wr * 4 + wc) * 64 + fq * 16 + fr;
            unsigned short* base = GATES + (size_t)((u.pm * 8 + ct) * 3 + br) * 65536 + (size_t)tid * 8;
#pragma unroll
            for (int ai = 0; ai < 2; ++ai)
#pragma unroll
                for (int m = 0; m < 4; ++m)
#pragma unroll
                    for (int bj = 0; bj < 2; ++bj) { f32x4 v0 = acc[ai][bj][m][0], v1 = acc[ai][bj][m][1];
#pragma unroll
                        for (int j = 0; j < 4; ++j) { v0[j] = __builtin_fmaxf(sigmoid_f(v0[j]), 6.2e-5f); v1[j] = __builtin_fmaxf(sigmoid_f(v1[j]), 6.2e-5f); }
                        u32x4 w; w.x = pk_f16(v0[0], v0[1]); w.y = pk_f16(v0[2], v0[3]); w.z = pk_f16(v1[0], v1[1]); w.w = pk_f16(v1[2], v1[3]);
                        *(u32x4*)(base + (size_t)((ai * 4 + m) * 2 + bj) * 4096) = w; }
        } else {
            const int pq = pn - 49; const int row0 = (u.pm - 32) * BM + wr * 64 + fr;
#pragma unroll
            for (int ai = 0; ai < 2; ++ai)
#pragma unroll
                for (int m = 0; m < 4; ++m) { const int row = row0 + ai * HALF + m * 16;
#pragma unroll
                    for (int bj = 0; bj < 2; ++bj) { const f32x4 v0 = acc[ai][bj][m][0], v1 = acc[ai][bj][m][1];
                        u32x4 w; w.x = cvt_pk_bf16(v0[0], v0[1]); w.y = cvt_pk_bf16(v0[2], v0[3]); w.z = cvt_pk_bf16(v1[0], v1[1]); w.w = cvt_pk_bf16(v1[2], v1[3]);
                        if (pq < 4) { *(u32x4*)(MK + (size_t)row * 1024 + pq * BM + bj * HALF + wc * 32 + 8 * fq) = w; }
                        else { const int b = row >> 8, mm = row & 255, d0 = bj * HALF + wc * 32 + 8 * fq;
                            bf16_t* vp = MVT + ((size_t)((b * 4 + (pq - 4)) * 256 + d0) << 8) + mm;
                            vp[0 << 8] = (bf16_t)(w.x & 0xffffu); vp[1 << 8] = (bf16_t)(w.x >> 16); vp[2 << 8] = (bf16_t)(w.y & 0xffffu); vp[3 << 8] = (bf16_t)(w.y >> 16);
                            vp[4 << 8] = (bf16_t)(w.z & 0xffffu); vp[5 << 8] = (bf16_t)(w.z >> 16); vp[6 << 8] = (bf16_t)(w.w & 0xffffu); vp[7 << 8] = (bf16_t)(w.w >> 16); } } }
        }
    }
};

struct EpiP3 {
    static constexpr bool PERM = true, AFTER_DRAIN = false, HAS_MID = true; static constexpr int MID0 = 16, MID1 = 32;
    const unsigned short* GATES; bf16_t* MERGED;
    __device__ __forceinline__ void mid(f32x4 (&acc)[2][2][4][2], const Unit& u, int t, int wr, int wc, int fr, int fq) const {
        const int br = (t == MID0) ? 0 : 1; const int tid = (wr * 4 + wc) * 64 + fq * 16 + fr;
        const unsigned short* g0 = GATES + (size_t)((u.pm * 8 + u.pn) * 3 + br) * 65536 + (size_t)tid * 8; const unsigned short* g1 = g0 + 65536;
#pragma unroll
        for (int ai = 0; ai < 2; ++ai)
#pragma unroll
            for (int m = 0; m < 4; ++m)
#pragma unroll
                for (int bj = 0; bj < 2; ++bj) { const size_t off = (size_t)((ai * 4 + m) * 2 + bj) * 4096;
                    const u32x4 a = *(const u32x4*)(g0 + off), b = *(const u32x4*)(g1 + off);
                    f32x4 r0, r1;
                    r0[0] = f16lo(a.x) * __builtin_amdgcn_rcpf(f16lo(b.x)); r0[1] = f16hi(a.x) * __builtin_amdgcn_rcpf(f16hi(b.x));
                    r0[2] = f16lo(a.y) * __builtin_amdgcn_rcpf(f16lo(b.y)); r0[3] = f16hi(a.y) * __builtin_amdgcn_rcpf(f16hi(b.y));
                    r1[0] = f16lo(a.z) * __builtin_amdgcn_rcpf(f16lo(b.z)); r1[1] = f16hi(a.z) * __builtin_amdgcn_rcpf(f16hi(b.z));
                    r1[2] = f16lo(a.w) * __builtin_amdgcn_rcpf(f16lo(b.w)); r1[3] = f16hi(a.w) * __builtin_amdgcn_rcpf(f16hi(b.w));
                    acc[ai][bj][m][0] = acc[ai][bj][m][0] * r0; acc[ai][bj][m][1] = acc[ai][bj][m][1] * r1; }
    }
    __device__ __forceinline__ void operator()(const f32x4 (&acc)[2][2][4][2], const Unit& u, int wr, int wc, int fr, int fq) const {
        const int tid = (wr * 4 + wc) * 64 + fq * 16 + fr;
        const unsigned short* g2 = GATES + (size_t)((u.pm * 8 + u.pn) * 3 + 2) * 65536 + (size_t)tid * 8;
        const int row0 = u.pm * BM + wr * 64 + fr, col0 = u.pn * BM + wc * 32 + 8 * fq;
#pragma unroll
        for (int ai = 0; ai < 2; ++ai)
#pragma unroll
            for (int m = 0; m < 4; ++m) { bf16_t* rowp = MERGED + (size_t)(row0 + ai * HALF + m * 16) * 2048 + col0;
#pragma unroll
                for (int bj = 0; bj < 2; ++bj) { const u32x4 a = *(const u32x4*)(g2 + (size_t)((ai * 4 + m) * 2 + bj) * 4096);
                    f32x4 v0 = acc[ai][bj][m][0], v1 = acc[ai][bj][m][1];
                    v0[0] *= f16lo(a.x); v0[1] *= f16hi(a.x); v0[2] *= f16lo(a.y); v0[3] *= f16hi(a.y);
                    v1[0] *= f16lo(a.z); v1[1] *= f16hi(a.z); v1[2] *= f16lo(a.w); v1[3] *= f16hi(a.w);
                    u32x4 w; w.x = cvt_pk_bf16(v0[0], v0[1]); w.y = cvt_pk_bf16(v0[2], v0[3]); w.z = cvt_pk_bf16(v1[0], v1[1]); w.w = cvt_pk_bf16(v1[2], v1[3]);
                    *(u32x4*)(rowp + bj * HALF) = w; } }
    }
};

struct EpiF32 {
    static constexpr bool PERM = false, AFTER_DRAIN = false, HAS_MID = false; static constexpr int MID0 = -1, MID1 = -1;
    float* C; int ldc;
    __device__ __forceinline__ void mid(f32x4 (&)[2][2][4][2], const Unit&, int, int, int, int, int) const {}
    __device__ __forceinline__ void operator()(const f32x4 (&acc)[2][2][4][2], const Unit& u, int wr, int wc, int fr, int fq) const {
        const int row0 = u.pm * BM + wr * 64 + fr, col0 = u.pn * BM + wc * 32 + 4 * fq;
#pragma unroll
        for (int ai = 0; ai < 2; ++ai)
#pragma unroll
            for (int m = 0; m < 4; ++m) { float* rowp = C + (size_t)(row0 + ai * HALF + m * 16) * ldc + col0;
#pragma unroll
                for (int bj = 0; bj < 2; ++bj)
#pragma unroll
                    for (int n = 0; n < 2; ++n) *(f32x4*)(rowp + bj * HALF + n * 16) = acc[ai][bj][m][n]; }
    }
};

template <class Epi, class Sched, bool ALIGN_EPI = false, bool SP2 = false>
__device__ __forceinline__ void gemm_phase(PG8_LAS unsigned char* lds, const Gemm g, const Sched& S, const Epi& E) {
    const int tid = threadIdx.x, wid = __builtin_amdgcn_readfirstlane(tid >> 6), lane = tid & 63, wr = wid >> 2, wc = wid & 3, fr = lane & 15, fq = lane >> 4;
    const int K = g.K, nt = K / BK;
    unsigned voffA[2], voffB[2];
#pragma unroll
    for (int i = 0; i < 2; ++i) { int R, C; stage_rc(tid * 16 + i * 8192, R, C); const int Rb = Epi::PERM ? ((R & ~31) + perm32(R & 31)) : R;
        voffA[i] = (unsigned)(R * K + C) * 2u; voffB[i] = (unsigned)(Rb * K + C) * 2u; }
    const size_t kstep = (size_t)(BK * 2);
    const size_t hstep = (size_t)HALF * K * 2;
    const size_t tstep = 2 * hstep;
    const unsigned ldsw = (unsigned)wid * 1024u;
    const int aoff = lds_byte(wr * 64 + fr, fq * 8), boff = lds_byte(wc * 32 + fr, fq * 8);
#define PG8_SA(b, h) (((b) * 2 + (h)) * HTB)
#define PG8_SB(b, h) ((4 + (b) * 2 + (h)) * HTB)
#define PG8_STAGE(bufoff, gbase, voff) do { _Pragma("unroll") for (int _i = 0; _i < 2; ++_i) \
        __builtin_amdgcn_global_load_lds((const unsigned*)((const char*)(gbase) + (voff)[_i]), (PG8_LAS unsigned*)(lds + (bufoff) + ldsw + _i * 8192), 16, 0, 0); } while (0)
#define PG8_LDA(dst, b, h) do { _Pragma("unroll") for (int m = 0; m < 4; ++m) _Pragma("unroll") for (int k = 0; k < 2; ++k) dst[m][k] = *(const PG8_LAS bf16x8*)(lds + PG8_SA(b, h) + aoff + m * 2048 + k * 1024); } while (0)
#define PG8_LDB(dst, b, h) do { _Pragma("unroll") for (int n = 0; n < 2; ++n) _Pragma("unroll") for (int k = 0; k < 2; ++k) dst[n][k] = *(const PG8_LAS bf16x8*)(lds + PG8_SB(b, h) + boff + n * 2048 + k * 1024); } while (0)
#define PG8_MMA(ai, bj, At, Bt) do { __builtin_amdgcn_s_setprio(1); _Pragma("unroll") for (int m = 0; m < 4; ++m) _Pragma("unroll") for (int n = 0; n < 2; ++n) _Pragma("unroll") for (int k = 0; k < 2; ++k) \
        acc[ai][bj][m][n] = __builtin_amdgcn_mfma_f32_16x16x32_bf16(Bt[n][k], At[m][k], acc[ai][bj][m][n], 0, 0, 0); __builtin_amdgcn_s_setprio(0); } while (0)
#define PG8_WAIT_V(n) asm volatile("s_waitcnt vmcnt(" #n ")" ::: "memory")
#define PG8_WAIT_L(n) asm volatile("s_waitcnt lgkmcnt(" #n ")" ::: "memory")
#define PG8_BAR __builtin_amdgcn_s_barrier()
#define PG8_SCHED __builtin_amdgcn_sched_barrier(0)
    Unit cur, nxt; int ui = 0;
    if (!S.next(0, cur)) return;
    f32x4 acc[2][2][4][2];
#pragma unroll
    for (int a = 0; a < 2; ++a)
#pragma unroll
        for (int b = 0; b < 2; ++b)
#pragma unroll
            for (int m = 0; m < 4; ++m)
#pragma unroll
                for (int n = 0; n < 2; ++n) acc[a][b][m][n] = (f32x4){0.f, 0.f, 0.f, 0.f};
    bf16x8 At[4][2], B0[2][2], B1[2][2];
    const char* cA = (const char*)g.A + (size_t)cur.pm * tstep; const char* cB = (const char*)g.Bt + (size_t)cur.pn * tstep;
    S.a_ready(cur);
    if constexpr (SP2) {
        PG8_STAGE(PG8_SB(0, 0), cB, voffB); PG8_STAGE(PG8_SB(0, 1), cB + hstep, voffB); PG8_STAGE(PG8_SA(0, 0), cA, voffA); PG8_STAGE(PG8_SA(0, 1), cA + hstep, voffA);
        if (wr == 1) PG8_BAR;
        PG8_WAIT_V(2); PG8_BAR;
        PG8_STAGE(PG8_SB(1, 0), cB + kstep, voffB); PG8_STAGE(PG8_SA(1, 0), cA + kstep, voffA); PG8_STAGE(PG8_SB(1, 1), cB + hstep + kstep, voffB);
        PG8_WAIT_V(6); PG8_BAR;
    } else {
        PG8_STAGE(PG8_SB(0, 0), cB, voffB); PG8_STAGE(PG8_SA(0, 0), cA, voffA); PG8_STAGE(PG8_SB(0, 1), cB + hstep, voffB); PG8_STAGE(PG8_SA(0, 1), cA + hstep, voffA);
        if (wr == 1) PG8_BAR;
        PG8_WAIT_V(4); PG8_BAR;
        PG8_STAGE(PG8_SB(1, 0), cB + kstep, voffB); PG8_STAGE(PG8_SA(1, 0), cA + kstep, voffA); PG8_STAGE(PG8_SB(1, 1), cB + hstep + kstep, voffB);
        PG8_WAIT_V(6); PG8_BAR;
    }
    for (;;) {
        const bool has_next = S.next(ui + 1, nxt);
        const char* nA = has_next ? (const char*)g.A + (size_t)nxt.pm * tstep : cA; const char* nB = has_next ? (const char*)g.Bt + (size_t)nxt.pn * tstep : cB;
        for (int t = 0; t < nt; t += 2) {
            const bool last = (t == nt - 2);
            if constexpr (Epi::HAS_MID) { if (t == Epi::MID0 || t == Epi::MID1) E.mid(acc, cur, t, wr, wc, fr, fq); }
            const char* a1 = cA + (size_t)(t + 1) * kstep;
            const char* a2 = last ? nA : cA + (size_t)(t + 2) * kstep; const char* b2 = last ? nB : cB + (size_t)(t + 2) * kstep;
            const char* a3 = a2 + kstep; const char* b3 = b2 + kstep;
            if (last && has_next) S.a_ready(nxt);
            if constexpr (SP2) {
            PG8_LDB(B0, 0, 0); PG8_LDB(B1, 0, 1); PG8_SCHED; PG8_LDA(At, 0, 0); PG8_STAGE(PG8_SA(1, 1), a1 + hstep, voffA);
            PG8_WAIT_V(8); PG8_WAIT_L(0); PG8_BAR; PG8_MMA(0, 0, At, B0); PG8_MMA(0, 1, At, B1); PG8_BAR; PG8_SCHED;
            PG8_LDA(At, 0, 1); PG8_STAGE(PG8_SB(0, 0), b2, voffB); PG8_STAGE(PG8_SB(0, 1), b2 + hstep, voffB); PG8_STAGE(PG8_SA(0, 0), a2, voffA);
            PG8_WAIT_V(8); PG8_WAIT_L(0); PG8_BAR; PG8_MMA(1, 0, At, B0); PG8_MMA(1, 1, At, B1); PG8_BAR; PG8_SCHED;
            PG8_LDB(B0, 1, 0); PG8_LDB(B1, 1, 1); PG8_SCHED; PG8_LDA(At, 1, 0); PG8_STAGE(PG8_SA(0, 1), a2 + hstep, voffA);
            PG8_WAIT_V(8); PG8_WAIT_L(0); PG8_BAR; PG8_MMA(0, 0, At, B0); PG8_MMA(0, 1, At, B1); PG8_BAR; PG8_SCHED;
            PG8_LDA(At, 1, 1); PG8_STAGE(PG8_SB(1, 0), b3, voffB); PG8_STAGE(PG8_SB(1, 1), b3 + hstep, voffB); PG8_STAGE(PG8_SA(1, 0), a3, voffA);
            PG8_WAIT_V(8); PG8_WAIT_L(0); PG8_BAR; PG8_MMA(1, 0, At, B0); PG8_MMA(1, 1, At, B1); PG8_BAR; PG8_SCHED;
            } else {
            PG8_LDB(B0, 0, 0); PG8_SCHED; PG8_LDA(At, 0, 0); PG8_STAGE(PG8_SA(1, 1), a1 + hstep, voffA);
            PG8_WAIT_L(8); PG8_BAR; PG8_WAIT_L(0); PG8_MMA(0, 0, At, B0); PG8_BAR; PG8_SCHED;
            PG8_LDB(B1, 0, 1); PG8_STAGE(PG8_SB(0, 0), b2, voffB);
            PG8_BAR; PG8_WAIT_L(0); PG8_MMA(0, 1, At, B1); PG8_BAR;
            PG8_LDA(At, 0, 1); PG8_STAGE(PG8_SA(0, 0), a2, voffA);
            PG8_BAR; PG8_WAIT_L(0); PG8_MMA(1, 0, At, B0); PG8_BAR; PG8_SCHED;
            PG8_STAGE(PG8_SB(0, 1), b2 + hstep, voffB);
            PG8_WAIT_V(6); PG8_BAR; PG8_MMA(1, 1, At, B1); PG8_BAR;
            PG8_LDB(B0, 1, 0); PG8_SCHED; PG8_LDA(At, 1, 0); PG8_STAGE(PG8_SA(0, 1), a2 + hstep, voffA);
            PG8_WAIT_L(8); PG8_BAR; PG8_WAIT_L(0); PG8_MMA(0, 0, At, B0); PG8_BAR; PG8_SCHED;
            PG8_LDB(B1, 1, 1); PG8_STAGE(PG8_SB(1, 0), b3, voffB);
            PG8_BAR; PG8_WAIT_L(0); PG8_MMA(0, 1, At, B1); PG8_BAR;
            PG8_LDA(At, 1, 1); PG8_STAGE(PG8_SA(1, 0), a3, voffA);
            PG8_BAR; PG8_WAIT_L(0); PG8_MMA(1, 0, At, B0); PG8_BAR; PG8_SCHED;
            PG8_STAGE(PG8_SB(1, 1), b3 + hstep, voffB);
            PG8_WAIT_V(6); PG8_BAR; PG8_MMA(1, 1, At, B1); PG8_BAR;
            }
        }
        if constexpr (ALIGN_EPI) { if (wr == 0) PG8_BAR; }
        if constexpr (!Epi::AFTER_DRAIN) { E(acc, cur, wr, wc, fr, fq); S.done(cur); }
        if (!has_next) break;
#pragma unroll
        for (int a = 0; a < 2; ++a)
#pragma unroll
            for (int b = 0; b < 2; ++b)
#pragma unroll
                for (int m = 0; m < 4; ++m)
#pragma unroll
                    for (int n = 0; n < 2; ++n) acc[a][b][m][n] = (f32x4){0.f, 0.f, 0.f, 0.f};
        cur = nxt; cA = nA; cB = nB; ++ui;
        if constexpr (ALIGN_EPI) { if (wr == 1) PG8_BAR; }
    }
    PG8_WAIT_V(0);
    if constexpr (!ALIGN_EPI) { if (wr == 0) PG8_BAR; }
    PG8_BAR;
    if constexpr (Epi::AFTER_DRAIN) { E.fused(acc, cur, wr, wc, fr, fq, lds, wid, lane); S.done(cur); }
#undef PG8_SA
#undef PG8_SB
#undef PG8_STAGE
#undef PG8_LDA
#undef PG8_LDB
#undef PG8_MMA
#undef PG8_WAIT_V
#undef PG8_WAIT_L
#undef PG8_BAR
#undef PG8_SCHED
}
}

#ifndef PG8_SP2
#define PG8_SP2 true
#endif
#ifndef PG8_ALIGN
#define PG8_ALIGN true
#endif
#define GAS __attribute__((address_space(1)))
#define LAS __attribute__((address_space(3)))
typedef unsigned short bf16;
typedef unsigned v4u __attribute__((ext_vector_type(4)));
typedef float f32x4 __attribute__((ext_vector_type(4)));
typedef short bf16x8 __attribute__((ext_vector_type(8)));
typedef GAS unsigned gu32;
typedef GAS unsigned long long gu64;
#define RLX_AGENT __ATOMIC_RELAXED, __HIP_MEMORY_SCOPE_AGENT
#define LDS_WAIT() asm volatile("s_waitcnt lgkmcnt(0)" ::: "memory")
#define VM_WAIT() asm volatile("s_waitcnt vmcnt(0)" ::: "memory")
__device__ __forceinline__ unsigned long long rt() { return __builtin_amdgcn_s_memrealtime(); }
__device__ __forceinline__ unsigned f2bf(float f) { unsigned u = __builtin_bit_cast(unsigned, f); return (u + 0x7fffu + ((u >> 16) & 1u)) >> 16; }
__device__ __forceinline__ unsigned pk2(float lo, float hi) { return f2bf(lo) | (f2bf(hi) << 16); }

#define XB_TMO      128
#define XB_XCNT(j)  (256  + 64 * (j))
#define XB_XSUB(j)  (1280 + 64 * (j))
#define XB_XGEN(j)  (2304 + 64 * (j))
#define XB_TOP      3328
#define XB_TOPGEN   3392
#define XCD_BAR_WORDS 3456
#define XB_SPIN_CAP (1u << 18)

__device__ __forceinline__ unsigned xb_ld(unsigned* p)              { return __hip_atomic_load(p, __ATOMIC_RELAXED, __HIP_MEMORY_SCOPE_AGENT); }
__device__ __forceinline__ unsigned xb_add(unsigned* p, unsigned v) { return __hip_atomic_fetch_add(p, v, __ATOMIC_RELAXED, __HIP_MEMORY_SCOPE_AGENT); }
__device__ __forceinline__ unsigned xb_xcc_id() { return (unsigned)__builtin_amdgcn_s_getreg((3 << 11) | 20) & 0xFu; }
#define XB_SPIN(cond, bar) do { unsigned _sp = 0; while (cond) { __builtin_amdgcn_s_sleep(1); \
    if ((++_sp & 255u) == 0u) { if (xb_ld(&(bar)[XB_TMO])) break; if (_sp > XB_SPIN_CAP) { atomicAdd(&(bar)[XB_TMO], 1u); break; } } } } while (0)

struct XcdBarrier {
    unsigned* bar; unsigned x;
    volatile LAS unsigned* st;
};

__device__ __forceinline__ XcdBarrier xcd_barrier_post(unsigned* bar, volatile LAS unsigned* st) {
    XcdBarrier b; b.bar = bar; b.x = xb_xcc_id(); b.st = st;
    if (threadIdx.x == 0) (void)xb_add(&bar[XB_XCNT(b.x)], 1u);
    return b;
}
__device__ __forceinline__ void xcd_barrier_complete(unsigned* bar, unsigned x, unsigned& nloc, unsigned& nx) {
    const unsigned G = gridDim.x * gridDim.y * gridDim.z;
    unsigned sum, cnt, mine, sp = 0u;
    for (;;) {
        sum = 0u; cnt = 0u; mine = 0u;
#pragma unroll
        for (unsigned j = 0; j < 16; ++j) { const unsigned c = xb_ld(&bar[XB_XCNT(j)]); sum += c; cnt += (c > 0u) ? 1u : 0u; mine = (j == x) ? c : mine; }
        if (sum == G) break;
        __builtin_amdgcn_s_sleep(1);
        if ((++sp & 255u) == 0u) { if (xb_ld(&bar[XB_TMO])) break; if (sp > XB_SPIN_CAP) { atomicAdd(&bar[XB_TMO], 1u); break; } }
    }
    nloc = mine > 0u ? mine : 1u; nx = cnt > 0u ? cnt : 1u;
}

__device__ __forceinline__ void xcd_barrier(const XcdBarrier& b) {
    asm volatile("s_waitcnt vmcnt(0)" ::: "memory");
    __syncthreads();
    if (threadIdx.x == 0) {
        unsigned* bar = b.bar;
        __builtin_amdgcn_s_waitcnt(0);
        unsigned nloc = b.st[0], nx = b.st[1];
        if (nloc == 0u) { xcd_barrier_complete(bar, b.x, nloc, nx); b.st[0] = nloc; b.st[1] = nx; }
        const unsigned old = xb_add(&bar[XB_XSUB(b.x)], 1u);
        const unsigned gen = old / nloc;
        if (old + 1u == (gen + 1u) * nloc) {
            __builtin_amdgcn_fence(__ATOMIC_RELEASE, "agent");
            asm volatile("s_waitcnt vmcnt(0)" ::: "memory");
            const unsigned og = xb_add(&bar[XB_TOP], 1u);
            const unsigned tg = og / nx;
            if (og + 1u == (tg + 1u) * nx) xb_add(&bar[XB_TOPGEN], 1u);
            else XB_SPIN(xb_ld(&bar[XB_TOPGEN]) == tg, bar);
            __builtin_amdgcn_fence(__ATOMIC_ACQUIRE, "agent");
            xb_add(&bar[XB_XGEN(b.x)], 1u);
            asm volatile("s_waitcnt vmcnt(0)" ::: "memory");
        } else {
            XB_SPIN(xb_ld(&bar[XB_XGEN(b.x)]) == gen, bar);
            __builtin_amdgcn_fence(__ATOMIC_ACQUIRE, "agent");
            asm volatile("s_waitcnt vmcnt(0)" ::: "memory");
        }
    }
    __syncthreads();
}


constexpr int NWAVES = 8;
constexpr int BATCH = 4, SEQ = 2048, DM = 2048, TOK = BATCH * SEQ, MEML = 256, MROWS = BATCH * MEML;
constexpr int D_RNN = 1024, D_IN = 12544, PLD = 6400, YLD = 3072;
constexpr int C_XR = 0, C_GRG = 1024, C_QS = 2048, C_KS = 3072, C_VS = 3200, C_GSWA = 3328, C_QM = 4352, C_GMEM = 5376;
constexpr float EPS = 1e-6f;
constexpr float LOG2E = 1.4426950408889634f;
__device__ const unsigned char REL_BUCKET[128] = {0, 1, 2, 3, 4, 5, 6, 7, 8, 9, 10, 11, 12, 13, 14, 15, 16, 16, 16, 17, 17, 18, 18, 18, 19, 19, 19, 20, 20, 20, 20, 21, 21, 21, 21, 22, 22, 22, 22, 22, 23, 23, 23, 23, 23, 23, 24, 24, 24, 24, 24, 24, 25, 25, 25, 25, 25, 25, 25, 26, 26, 26, 26, 26, 26, 26, 26, 27, 27, 27, 27, 27, 27, 27, 27, 27, 27, 28, 28, 28, 28, 28, 28, 28, 28, 28, 28, 29, 29, 29, 29, 29, 29, 29, 29, 29, 29, 29, 29, 30, 30, 30, 30, 30, 30, 30, 30, 30, 30, 30, 30, 30, 30, 31, 31, 31, 31, 31, 31, 31, 31, 31, 31, 31, 31, 31, 31, 31};

constexpr size_t MiB = 1u << 20;
constexpr size_t WS_CTL = 0, CTL_ZERO_BYTES = 1 * MiB;
constexpr size_t WS_WIN = 2 * MiB;
constexpr size_t WS_WMKV = 51 * MiB;
constexpr size_t WS_WBR = 59 * MiB;
constexpr size_t WS_WOUT = 71 * MiB;
constexpr size_t WS_H = 80 * MiB;
constexpr size_t WS_MEMN = 112 * MiB;
constexpr size_t WS_PROJ = 116 * MiB;
constexpr size_t WS_VT = 216 * MiB;
constexpr size_t WS_MK = 218 * MiB;
constexpr size_t WS_MVT = 220 * MiB;
constexpr size_t WS_GATES = 222 * MiB;
constexpr size_t WS_Y = 318 * MiB;
constexpr size_t WS_MERGED = WS_H;
constexpr size_t WS_OUT32 = WS_PROJ;
constexpr size_t WS_WF = 366 * MiB;
constexpr size_t WS_BIASF = 1 * MiB;
constexpr size_t WS_END = 368 * MiB;
static_assert(WS_WIN + (size_t)12544 * 2048 * 2 == WS_WMKV && WS_H + (size_t)TOK * DM * 2 == WS_MEMN && WS_PROJ + (size_t)TOK * PLD * 2 == WS_VT && WS_GATES + (size_t)768 * 131072 == WS_Y && WS_Y + (size_t)TOK * YLD * 2 == WS_WF && WS_WF + 2 * MiB == WS_END, "d_ws map");
constexpr int CW_TMO = 0, CW_CODE = 1;
constexpr int CW_BAR = 4096;

constexpr int RING_OFF = 0, RING_BYTES = 131072;
constexpr int LDSCTL_OFF = RING_BYTES, MISC_OFF = LDSCTL_OFF + 320;
constexpr int LDS_BYTES = 147456;
static_assert(MISC_OFF + 128 <= LDS_BYTES, "LDS map");


struct Frame {
    LAS unsigned char* lds;
    volatile LAS unsigned* MISC;
    gu32* ctl;
    int tid, lane, wave;
    int vcu, G;
    const float* in[20]; float* out; unsigned char* ws;
};
__device__ __forceinline__ float wave_sum(float v) {
#pragma unroll
    for (int o = 1; o < 64; o <<= 1) v += __shfl_xor(v, o);
    return v;
}
__device__ __forceinline__ float wave_max(float v) {
#pragma unroll
    for (int o = 1; o < 64; o <<= 1) v = __builtin_fmaxf(v, __shfl_xor(v, o));
    return v;
}
__device__ __forceinline__ float bf2f(bf16 u) { return __uint_as_float((unsigned)u << 16); }
__device__ __forceinline__ float bflo(unsigned w) { return __uint_as_float(w << 16); }
__device__ __forceinline__ float bfhi(unsigned w) { return __uint_as_float(w & 0xffff0000u); }

__device__ __forceinline__ void p0_transpose_item(const float* W, int N, bf16* WT, int ldt, int col_off, LAS float* scr, int item, int lane) {
    const int nblk = N / 32, kb = item / nblk, nb = item % nblk, k0 = 64 * kb, n0 = 32 * nb;
#pragma unroll 8
    for (int i = 0; i < 32; ++i) { const int kk = 2 * i + (lane >> 5); scr[kk * 33 + (lane & 31)] = W[(size_t)(k0 + kk) * N + n0 + (lane & 31)]; }
    LDS_WAIT(); asm volatile("" ::: "memory");
    const int c = lane & 7;
#pragma unroll
    for (int j = 0; j < 4; ++j) { const int n = (lane >> 3) + 8 * j; const LAS float* s = scr + (8 * c) * 33 + n;
        v4u o; o.x = pk2(s[0 * 33], s[1 * 33]); o.y = pk2(s[2 * 33], s[3 * 33]); o.z = pk2(s[4 * 33], s[5 * 33]); o.w = pk2(s[6 * 33], s[7 * 33]);
        *(GAS v4u*)(WT + (size_t)(n0 + n) * ldt + col_off + k0 + 8 * c) = o; }
    LDS_WAIT(); asm volatile("" ::: "memory");
}
__device__ __forceinline__ void rms_row_to_bf16(int lane, const float* xrow, const float* g, bf16* orow) {
    const GAS f32x4* xr = (const GAS f32x4*)xrow + lane; const GAS f32x4* gr = (const GAS f32x4*)g + lane;
    f32x4 v[8]; float s = 0.f;
#pragma unroll
    for (int j = 0; j < 8; ++j) { v[j] = xr[64 * j]; s += (v[j].x * v[j].x + v[j].y * v[j].y) + (v[j].z * v[j].z + v[j].w * v[j].w); }
    const float rstd = 1.0f / sqrtf(wave_sum(s) * (1.f / DM) + EPS);
    GAS unsigned long long* o8 = (GAS unsigned long long*)orow + lane;
#pragma unroll
    for (int j = 0; j < 8; ++j) { const f32x4 gg = gr[64 * j];
        o8[64 * j] = (unsigned long long)pk2(v[j].x * rstd * gg.x, v[j].y * rstd * gg.y) | ((unsigned long long)pk2(v[j].z * rstd * gg.z, v[j].w * rstd * gg.w) << 32); }
}
__device__ __forceinline__ void p0_prologue(Frame& F) {
    LAS float* scr = (LAS float*)(F.lds + RING_OFF + F.wave * 16384);
    const int gw = F.vcu * NWAVES + F.wave, NGW = F.G * NWAVES;
    constexpr int I_IN = (DM / 64) * (D_IN / 32), I_MKV = (DM / 64) * (2048 / 32), I_BR = (1024 / 64) * (DM / 32), I_OUT = (DM / 64) * (DM / 32);
    constexpr int NITEMS = I_IN + I_MKV + 3 * I_BR + I_OUT;
    bf16* WinT = (bf16*)(F.ws + WS_WIN); bf16* WmkvT = (bf16*)(F.ws + WS_WMKV); bf16* WbrT = (bf16*)(F.ws + WS_WBR); bf16* WoutT = (bf16*)(F.ws + WS_WOUT);
    for (int it = gw; it < NITEMS; it += NGW) {
        int r = it;
        if (r < I_IN) { p0_transpose_item(F.in[5], D_IN, WinT, DM, 0, scr, r, F.lane); continue; } r -= I_IN;
        if (r < I_MKV) { p0_transpose_item(F.in[15], 2048, WmkvT, DM, 0, scr, r, F.lane); continue; } r -= I_MKV;
        if (r < I_BR) { p0_transpose_item(F.in[16], DM, WbrT, YLD, 0, scr, r, F.lane); continue; } r -= I_BR;
        if (r < I_BR) { p0_transpose_item(F.in[17], DM, WbrT, YLD, 1024, scr, r, F.lane); continue; } r -= I_BR;
        if (r < I_BR) { p0_transpose_item(F.in[18], DM, WbrT, YLD, 2048, scr, r, F.lane); continue; } r -= I_BR;
        p0_transpose_item(F.in[19], DM, WoutT, DM, 0, scr, r, F.lane);
    }
    {
        const int gt0 = F.vcu * (NWAVES * 64) + F.tid, GT = F.G * NWAVES * 64;
        for (int gt = gt0; gt < 8 * 8 * 2 * 4 * 4 * 64; gt += GT) {
            const int ln = gt & 63, kk = (gt >> 6) & 3, tap = (gt >> 8) & 3, g = (gt >> 10) & 1, jg = (gt >> 11) & 7, n = gt >> 14;
            const float* wg = g ? F.in[10] : F.in[8]; const float* cw = F.in[6] + tap * 1024 + n * 128;
            const int i0 = 32 * kk + 8 * (ln >> 4), jc = jg * 16 + (ln & 15);
            float v[8];
#pragma unroll
            for (int e = 0; e < 8; ++e) v[e] = cw[i0 + e] * wg[(size_t)(n * 128 + i0 + e) * 128 + jc];
            v4u o; o.x = pk2(v[0], v[1]); o.y = pk2(v[2], v[3]); o.z = pk2(v[4], v[5]); o.w = pk2(v[6], v[7]);
            *(GAS v4u*)((bf16*)(F.ws + WS_WF) + (size_t)gt * 8) = o;
        }
        for (int gt = gt0; gt < 2048; gt += GT) { const int g = gt >> 10, c = gt & 1023, n = c >> 7, j = c & 127;
            const float* wg = g ? F.in[10] : F.in[8]; const float* cb = F.in[7] + n * 128;
            float s = (g ? F.in[11] : F.in[9])[c];
            for (int i = 0; i < 128; ++i) s += cb[i] * wg[(size_t)(n * 128 + i) * 128 + j];
            ((float*)(F.ws + WS_BIASF))[gt] = s; }
    }
    bf16* H = (bf16*)(F.ws + WS_H); bf16* MEMN = (bf16*)(F.ws + WS_MEMN);
    for (int m = gw; m < TOK; m += NGW) rms_row_to_bf16(F.lane, F.in[0] + (size_t)m * DM, F.in[2], H + (size_t)m * DM);
    for (int m = gw; m < MROWS; m += NGW) rms_row_to_bf16(F.lane, F.in[1] + (size_t)m * DM, F.in[4], MEMN + (size_t)m * DM);
}

__device__ __forceinline__ void p2_rglru_gates_naive(Frame& F) {
    const bf16* PROJ = (const bf16*)(F.ws + WS_PROJ); float* AB = F.out;
    const float* conv_w = F.in[6]; const float* conv_b = F.in[7]; const float* w_a = F.in[8]; const float* b_a = F.in[9]; const float* w_x = F.in[10]; const float* b_x = F.in[11]; const float* lam = F.in[12];
    LAS float* cb = (LAS float*)(F.lds) + F.wave * 128;
    const int gw = F.vcu * NWAVES + F.wave, NGW = F.G * NWAVES, lane = F.lane;
    for (int task = gw; task < TOK * 8; task += NGW) {
        const int row = task >> 3, n = task & 7, t = row & (SEQ - 1);
        float cv[2];
#pragma unroll
        for (int q = 0; q < 2; ++q) { const int c = n * 128 + lane + 64 * q; float s = conv_b[c];
#pragma unroll
            for (int k = 0; k < 4; ++k) if (t - k >= 0) s += conv_w[k * 1024 + c] * bf2f(PROJ[(size_t)(row - k) * PLD + C_XR + c]);
            cv[q] = s; cb[lane + 64 * q] = s; }
        LDS_WAIT(); asm volatile("" ::: "memory");
        float ga[2], gx[2];
#pragma unroll
        for (int q = 0; q < 2; ++q) { const int c = n * 128 + lane + 64 * q; ga[q] = b_a[c]; gx[q] = b_x[c]; }
        for (int i = 0; i < 128; ++i) { const float x = cb[i];
#pragma unroll
            for (int q = 0; q < 2; ++q) { const int j = lane + 64 * q; ga[q] += x * w_a[(size_t)(n * 128 + i) * 128 + j]; gx[q] += x * w_x[(size_t)(n * 128 + i) * 128 + j]; } }
#pragma unroll
        for (int q = 0; q < 2; ++q) { const int c = n * 128 + lane + 64 * q;
            const float r = 1.0f / (1.0f + expf(-ga[q])), ii = 1.0f / (1.0f + expf(-gx[q]));
            const float sp = log1pf(expf(-lam[c]));
            const float log_a = -8.0f * r * sp, a = expf(log_a);
            const float mult = (t == 0) ? 1.0f : sqrtf(-expm1f(2.0f * log_a));
            const float bb = mult * ii * cv[q];
            *(float2*)(AB + ((size_t)row * 1024 + c) * 2) = make_float2(a, bb); }
        LDS_WAIT(); asm volatile("" ::: "memory");
    }
}
__device__ __forceinline__ void p2_rglru_scan_naive(Frame& F) {
    const bf16* PROJ = (const bf16*)(F.ws + WS_PROJ); const float* AB = F.out; bf16* Y = (bf16*)(F.ws + WS_Y);
    const int gid = F.vcu * (NWAVES * 64) + F.tid;
    if (gid < BATCH * 1024) {
        const int b = gid >> 10, c = gid & 1023; float h = 0.f;
#pragma unroll 8
        for (int t = 0; t < SEQ; ++t) { const size_t row = (size_t)b * SEQ + t; const float2 ab = *(const float2*)(AB + (row * 1024 + c) * 2);
            h = ab.x * h + ab.y; if (t == 0) h = ab.y;
            Y[row * YLD + c] = (bf16)f2bf(h * bf2f(PROJ[row * PLD + C_GRG + c])); }
    }
}
__device__ __forceinline__ void p2_swa_naive(Frame& F) {
    const bf16* PROJ = (const bf16*)(F.ws + WS_PROJ); const bf16* VT = (const bf16*)(F.ws + WS_VT); bf16* Y = (bf16*)(F.ws + WS_Y);
    const float* sinks = F.in[13]; const float* rel_bias = F.in[14];
    const int gw = F.vcu * NWAVES + F.wave, NGW = F.G * NWAVES, lane = F.lane;
    for (int task = gw; task < TOK * 16; task += NGW) {
        const int row = task >> 4, h = task & 15, kvh = h >> 3, b = row >> 11, t = row & (SEQ - 1);
        const v4u* qp = (const v4u*)(PROJ + (size_t)row * PLD + C_QS + h * 64);
        v4u q[8];
#pragma unroll
        for (int i = 0; i < 8; ++i) q[i] = qp[i];
        float s[2]; bool valid[2];
#pragma unroll
        for (int i = 0; i < 2; ++i) { const int dist = lane + 64 * i; valid[i] = (t - dist >= 0); s[i] = -1e30f;
            if (valid[i]) { const v4u* kp = (const v4u*)(PROJ + (size_t)(row - dist) * PLD + C_KS + kvh * 64); float d = 0.f;
#pragma unroll
                for (int c = 0; c < 8; ++c) { const v4u kk = kp[c];
                    d += bflo(q[c].x) * bflo(kk.x) + bfhi(q[c].x) * bfhi(kk.x) + bflo(q[c].y) * bflo(kk.y) + bfhi(q[c].y) * bfhi(kk.y)
                       + bflo(q[c].z) * bflo(kk.z) + bfhi(q[c].z) * bfhi(kk.z) + bflo(q[c].w) * bflo(kk.w) + bfhi(q[c].w) * bfhi(kk.w); }
                s[i] = d + LOG2E * rel_bias[REL_BUCKET[dist] * 16 + h]; } }
        const float sink2 = LOG2E * sinks[h];
        const float mx = __builtin_fmaxf(wave_max(__builtin_fmaxf(s[0], s[1])), sink2);
        float p[2];
#pragma unroll
        for (int i = 0; i < 2; ++i) p[i] = valid[i] ? exp2f(s[i] - mx) : 0.f;
        const float l = wave_sum(p[0] + p[1]) + exp2f(sink2 - mx);
        float o = 0.f;
        for (int d = 0; d < 64; ++d) { const bf16* vt = VT + ((size_t)((b * 2 + kvh) * 64 + d) << 11);
            float v = 0.f;
            if (valid[0]) v += p[0] * bf2f(vt[t - lane]);
            if (valid[1]) v += p[1] * bf2f(vt[t - lane - 64]);
            v = wave_sum(v); if (lane == d) o = v; }
        const float g = bf2f(PROJ[(size_t)row * PLD + C_GSWA + h * 64 + lane]);
        Y[(size_t)row * YLD + 1024 + h * 64 + lane] = (bf16)f2bf(o / l * g);
    }
}
__device__ __forceinline__ void p2_mem_naive(Frame& F) {
    const bf16* PROJ = (const bf16*)(F.ws + WS_PROJ); const bf16* MK = (const bf16*)(F.ws + WS_MK); const bf16* MVT = (const bf16*)(F.ws + WS_MVT); bf16* Y = (bf16*)(F.ws + WS_Y);
    const int gw = F.vcu * NWAVES + F.wave, NGW = F.G * NWAVES, lane = F.lane;
    for (int task = gw; task < TOK * 4; task += NGW) {
        const int row = task >> 2, h = task & 3, b = row >> 11;
        const v4u* qp = (const v4u*)(PROJ + (size_t)row * PLD + C_QM + h * 256);
        float s[4] = {0.f, 0.f, 0.f, 0.f};
        for (int c = 0; c < 32; ++c) { const v4u qq = qp[c];
#pragma unroll
            for (int i = 0; i < 4; ++i) { const v4u kk = *((const v4u*)(MK + (size_t)(b * 256 + lane + 64 * i) * 1024 + h * 256) + c);
                s[i] += bflo(qq.x) * bflo(kk.x) + bfhi(qq.x) * bfhi(kk.x) + bflo(qq.y) * bflo(kk.y) + bfhi(qq.y) * bfhi(kk.y)
                      + bflo(qq.z) * bflo(kk.z) + bfhi(qq.z) * bfhi(kk.z) + bflo(qq.w) * bflo(kk.w) + bfhi(qq.w) * bfhi(kk.w); } }
        const float mx = wave_max(__builtin_fmaxf(__builtin_fmaxf(s[0], s[1]), __builtin_fmaxf(s[2], s[3])));
        float p[4];
#pragma unroll
        for (int i = 0; i < 4; ++i) p[i] = exp2f(s[i] - mx);
        const float l = wave_sum((p[0] + p[1]) + (p[2] + p[3]));
        float o[4] = {0.f, 0.f, 0.f, 0.f};
        for (int d = 0; d < 256; ++d) { const bf16* vt = MVT + ((size_t)((b * 4 + h) * 256 + d) << 8);
            float v = p[0] * bf2f(vt[lane]) + p[1] * bf2f(vt[lane + 64]) + p[2] * bf2f(vt[lane + 128]) + p[3] * bf2f(vt[lane + 192]);
            v = wave_sum(v);
            if (lane == (d & 63)) { if ((d >> 6) == 0) o[0] = v; else if ((d >> 6) == 1) o[1] = v; else if ((d >> 6) == 2) o[2] = v; else o[3] = v; } }
#pragma unroll
        for (int i = 0; i < 4; ++i) { const int d = lane + 64 * i; const float g = bf2f(PROJ[(size_t)row * PLD + C_GMEM + h * 256 + d]);
            Y[(size_t)row * YLD + 2048 + h * 256 + d] = (bf16)f2bf(o[i] / l * g); }
    }
}

typedef float f32x16 __attribute__((ext_vector_type(16)));
typedef short s16x4 __attribute__((ext_vector_type(4)));
__device__ __forceinline__ unsigned cvtpk(float lo, float hi) { unsigned r; asm volatile("v_cvt_pk_bf16_f32 %0, %1, %2" : "=v"(r) : "v"(lo), "v"(hi)); return r; }

constexpr int RG_WFL = 0, RG_LA = 32768, RG_SSTR = 272, RG_LB = RG_LA + 32 * RG_SSTR * 4, RG_PA = RG_LB + 32 * RG_SSTR * 4, RG_PH = RG_PA + 2048, RG_CIN = RG_PH + 2048, RG_HC = RG_CIN + 2048 + 64;
static_assert(RG_HC + 64 <= RING_BYTES, "rglru LDS");
__device__ __forceinline__ void p2_rglru_item(Frame& F, int item) {
    const int b = item >> 6, n = (item >> 3) & 7, jg = item & 7;
    const bf16* PROJ = (const bf16*)(F.ws + WS_PROJ); bf16* Y = (bf16*)(F.ws + WS_Y);
    const int tid = F.tid, lane = F.lane, wave = F.wave;
    LAS unsigned char* L = F.lds;
    {
        const GAS v4u* src = (const GAS v4u*)((const bf16*)(F.ws + WS_WF) + (size_t)(item & 63) * (32 * 512));
#pragma unroll
        for (int i = 0; i < 4; ++i) *(LAS v4u*)(L + RG_WFL + (tid + 512 * i) * 16) = src[tid + 512 * i];
        if (tid < 16) *(LAS float*)(L + RG_HC + tid * 4) = 0.f;
    }
    const int jc = lane & 15, rq = lane >> 4;
    const int cg = n * 128 + jg * 16 + jc;
    const float cw0 = F.in[6][cg], cw1 = F.in[6][1024 + cg], cw2 = F.in[6][2048 + cg], cw3 = F.in[6][3072 + cg], cbv = F.in[7][cg];
    const float biasA = ((const float*)(F.ws + WS_BIASF))[cg], biasX = ((const float*)(F.ws + WS_BIASF))[1024 + cg];
    const float sp8 = 8.0f * log1pf(expf(-F.in[12][cg]));
    __syncthreads();
    const bf16* xbase = PROJ + (size_t)b * SEQ * PLD + C_XR + n * 128;
    for (int seg = 0; seg < 4; ++seg) {
#pragma unroll 1
        for (int ch = 0; ch < 4; ++ch) {
            const int t0 = seg * 512 + wave * 64 + ch * 16;
            pg8::f32x4 acca = {0.f, 0.f, 0.f, 0.f}, accx = {0.f, 0.f, 0.f, 0.f};
#pragma unroll
            for (int tap = 0; tap < 4; ++tap) { const int tt = t0 + (lane & 15) - tap;
#pragma unroll
                for (int kk = 0; kk < 4; ++kk) {
                    bf16x8 a = {0, 0, 0, 0, 0, 0, 0, 0};
                    if (tt >= 0) a = *(const bf16x8*)(xbase + (size_t)tt * PLD + 32 * kk + 8 * rq);
                    const bf16x8 ba = *(const LAS bf16x8*)(L + RG_WFL + (((0 * 4 + tap) * 4 + kk) * 64 + lane) * 16);
                    const bf16x8 bx = *(const LAS bf16x8*)(L + RG_WFL + (((1 * 4 + tap) * 4 + kk) * 64 + lane) * 16);
                    acca = __builtin_amdgcn_mfma_f32_16x16x32_bf16(a, ba, acca, 0, 0, 0);
                    accx = __builtin_amdgcn_mfma_f32_16x16x32_bf16(a, bx, accx, 0, 0, 0); } }
            const int tb = t0 + 4 * rq; float xv[7];
#pragma unroll
            for (int i = 0; i < 7; ++i) { const int tt = tb - 3 + i; xv[i] = (tt >= 0) ? bf2f(xbase[(size_t)tt * PLD + jg * 16 + jc]) : 0.f; }
            const int s = wave * 4 + ch;
#pragma unroll
            for (int r = 0; r < 4; ++r) {
                const float conv = cbv + cw0 * xv[3 + r] + cw1 * xv[2 + r] + cw2 * xv[1 + r] + cw3 * xv[r];
                const float rg = 1.0f / (1.0f + __expf(-(acca[r] + biasA))), ig = 1.0f / (1.0f + __expf(-(accx[r] + biasX)));
                const float log_a = -rg * sp8, av = __expf(log_a);
                const float mult = (tb + r == 0) ? 1.0f : sqrtf(-expm1f(2.0f * log_a));
                const int idx = s * RG_SSTR + (4 * rq + r) * 16 + jc;
                *(LAS float*)(L + RG_LA + idx * 4) = av; *(LAS float*)(L + RG_LB + idx * 4) = mult * ig * conv; }
        }
        __syncthreads();
        const int s1 = tid >> 4, c1 = tid & 15;
        { float A = 1.f, h = 0.f;
#pragma unroll
          for (int i = 0; i < 16; ++i) { const int idx = s1 * RG_SSTR + i * 16 + c1; const float a = *(const LAS float*)(L + RG_LA + idx * 4), bb = *(const LAS float*)(L + RG_LB + idx * 4); h = a * h + bb; A *= a; }
          *(LAS float*)(L + RG_PA + tid * 4) = A; *(LAS float*)(L + RG_PH + tid * 4) = h; }
        __syncthreads();
        { const int c2 = tid >> 5, s2 = tid & 31;
          float A = *(const LAS float*)(L + RG_PA + (s2 * 16 + c2) * 4), h = *(const LAS float*)(L + RG_PH + (s2 * 16 + c2) * 4);
          const float hc = *(const LAS float*)(L + RG_HC + c2 * 4);
#pragma unroll
          for (int d = 1; d < 32; d <<= 1) { const float Ap = __shfl_up(A, d, 32), hp = __shfl_up(h, d, 32); if (s2 >= d) { h = A * hp + h; A = A * Ap; } }
          const float hout = A * hc + h;
          if (s2 == 0) *(LAS float*)(L + RG_CIN + c2 * 4) = hc;
          if (s2 < 31) *(LAS float*)(L + RG_CIN + ((s2 + 1) * 16 + c2) * 4) = hout; else *(LAS float*)(L + RG_HC + c2 * 4) = hout; }
        __syncthreads();
        { float h = *(const LAS float*)(L + RG_CIN + tid * 4);
          const size_t row0 = (size_t)b * SEQ + seg * 512 + s1 * 16; const int col = n * 128 + jg * 16 + c1;
          float g[16];
#pragma unroll
          for (int i = 0; i < 16; ++i) g[i] = bf2f(PROJ[(row0 + i) * PLD + C_GRG + col]);
#pragma unroll
          for (int i = 0; i < 16; ++i) { const int idx = s1 * RG_SSTR + i * 16 + c1; const float a = *(const LAS float*)(L + RG_LA + idx * 4), bb = *(const LAS float*)(L + RG_LB + idx * 4);
              h = a * h + bb; Y[(row0 + i) * YLD + col] = (bf16)f2bf(h * g[i]); } }
        __syncthreads();
    }
}

constexpr int SW_K = 0, SW_V = 36864, SW_BT = SW_V + 64 * 520, SW_LW = SW_BT + 8192, SW_OST = SW_LW + 1024, SW_END = SW_OST + 8 * 4096;
static_assert(SW_END <= RING_BYTES, "swa LDS");
__device__ __forceinline__ void p2_swa_item(Frame& F, int item) {
    const int b = item >> 6, nb = (item >> 2) & 15, kvh = (item >> 1) & 1, hh = item & 1;
    const bf16* PROJ = (const bf16*)(F.ws + WS_PROJ); const bf16* VT = (const bf16*)(F.ws + WS_VT); bf16* Y = (bf16*)(F.ws + WS_Y);
    const int tid = F.tid, lane = F.lane, wave = F.wave;
    LAS unsigned char* L = F.lds;
    typedef unsigned u32x2 __attribute__((ext_vector_type(2)));
    {
        const int row = tid >> 1, half = tid & 1;
        if (nb > 0 || row >= 128) { const GAS v4u* src = (const GAS v4u*)(PROJ + (size_t)(b * SEQ + nb * 128 - 128 + row) * PLD + C_KS + kvh * 64 + half * 32);
#pragma unroll
            for (int i = 0; i < 4; ++i) *(LAS v4u*)(L + SW_K + row * 144 + half * 64 + 16 * i) = src[i]; }
        const int d = tid >> 3, part = tid & 7;
        if (nb > 0 || part >= 4) { const GAS u32x2* src = (const GAS u32x2*)(VT + ((size_t)((b * 2 + kvh) * 64 + d) << 11) + nb * 128 - 128 + part * 32);
#pragma unroll
            for (int i = 0; i < 8; ++i) *(LAS u32x2*)(L + SW_V + d * 520 + part * 64 + 8 * i) = src[i]; }
        else {
#pragma unroll
            for (int i = 0; i < 8; ++i) *(LAS u32x2*)(L + SW_V + d * 520 + part * 64 + 8 * i) = (u32x2){0u, 0u}; }
        const int rel = tid - 255; const bool ok = (rel >= 1 && rel <= 128); const int dist = ok ? 128 - rel : 0;
#pragma unroll
        for (int hl = 0; hl < 4; ++hl) { const int h = kvh * 8 + hh * 4 + hl;
            *(LAS float*)(L + SW_BT + (hl * 512 + tid) * 4) = ok ? LOG2E * F.in[14][REL_BUCKET[dist] * 16 + h] : -1e30f; }
    }
    __syncthreads();
    const int ql = lane & 31, hi = lane >> 5;
#pragma unroll 1
    for (int ti = 0; ti < 2; ++ti) {
        const int task = wave * 2 + ti, hl = task >> 2, qg = task & 3, h = kvh * 8 + hh * 4 + hl;
        const size_t rowq = (size_t)b * SEQ + nb * 128 + 32 * qg + ql;
        bf16x8 qf[4];
#pragma unroll
        for (int s = 0; s < 4; ++s) qf[s] = *(const bf16x8*)(PROJ + rowq * PLD + C_QS + h * 64 + 16 * s + 8 * hi);
        f32x16 p[5];
#pragma unroll
        for (int si = 0; si < 5; ++si) {
            const int st = qg + si;
            if (nb == 0 && st < 4) {
#pragma unroll
                for (int r = 0; r < 16; ++r) p[si][r] = -1e30f;
            } else {
                const LAS float* bt = (const LAS float*)(L + SW_BT) + hl * 512 + (32 * si + 4 * hi - ql + 255);
#pragma unroll
                for (int r = 0; r < 16; ++r) p[si][r] = bt[(r & 3) + 8 * (r >> 2)];
#pragma unroll
                for (int s = 0; s < 4; ++s) { const bf16x8 kf = *(const LAS bf16x8*)(L + SW_K + (32 * st + ql) * 144 + (16 * s + 8 * hi) * 2);
                    p[si] = __builtin_amdgcn_mfma_f32_32x32x16_bf16(kf, qf[s], p[si], 0, 0, 0); }
            }
        }
        float mx = -1e30f;
#pragma unroll
        for (int si = 0; si < 5; ++si)
#pragma unroll
            for (int r = 0; r < 16; ++r) mx = __builtin_fmaxf(mx, p[si][r]);
        mx = __builtin_fmaxf(mx, __shfl_xor(mx, 32));
        const float sink2 = LOG2E * F.in[13][h];
        mx = __builtin_fmaxf(mx, sink2);
        float sum = 0.f;
#pragma unroll
        for (int si = 0; si < 5; ++si)
#pragma unroll
            for (int r = 0; r < 16; ++r) { p[si][r] = __builtin_amdgcn_exp2f(p[si][r] - mx); sum += p[si][r]; }
        sum += __shfl_xor(sum, 32);
        const float l = sum + __builtin_amdgcn_exp2f(sink2 - mx);
        f32x16 o[2];
#pragma unroll
        for (int r = 0; r < 16; ++r) { o[0][r] = 0.f; o[1][r] = 0.f; }
#pragma unroll
        for (int si = 0; si < 5; ++si) {
            const int st = qg + si;
            if (!(nb == 0 && st < 4)) {
#pragma unroll
                for (int s2 = 0; s2 < 2; ++s2) {
                    v4u pw; pw.x = cvtpk(p[si][8 * s2 + 0], p[si][8 * s2 + 1]); pw.y = cvtpk(p[si][8 * s2 + 2], p[si][8 * s2 + 3]); pw.z = cvtpk(p[si][8 * s2 + 4], p[si][8 * s2 + 5]); pw.w = cvtpk(p[si][8 * s2 + 6], p[si][8 * s2 + 7]);
                    const bf16x8 pa = __builtin_bit_cast(bf16x8, pw);
#pragma unroll
                    for (int db = 0; db < 2; ++db) { const LAS unsigned char* vp = L + SW_V + (32 * db + ql) * 520 + (32 * st + 16 * s2 + 4 * hi) * 2;
                        const u32x2 v0 = *(const LAS u32x2*)vp, v1 = *(const LAS u32x2*)(vp + 16);
                        v4u vw; vw.x = v0.x; vw.y = v0.y; vw.z = v1.x; vw.w = v1.y;
                        o[db] = __builtin_amdgcn_mfma_f32_32x32x16_bf16(pa, __builtin_bit_cast(bf16x8, vw), o[db], 0, 0, 0); }
                }
            }
        }
        LAS float* lw = (LAS float*)(L + SW_LW) + wave * 32;
        if (hi == 0) lw[ql] = l;
        LDS_WAIT(); asm volatile("" ::: "memory");
        float rl[16];
#pragma unroll
        for (int r = 0; r < 16; ++r) rl[r] = __builtin_amdgcn_rcpf(lw[(r & 3) + 8 * (r >> 2) + 4 * hi]);
        LAS float* stg = (LAS float*)(L + SW_OST + wave * 4096);
#pragma unroll
        for (int db = 0; db < 2; ++db) {
#pragma unroll
            for (int r = 0; r < 16; ++r) stg[((r & 3) + 8 * (r >> 2) + 4 * hi) * 32 + ql] = o[db][r] * rl[r];
            LDS_WAIT(); asm volatile("" ::: "memory");
#pragma unroll
            for (int i = 0; i < 4; ++i) { const int row = i * 8 + (lane >> 3), cq = lane & 7;
                const f32x4 v = *(const LAS f32x4*)(stg + row * 32 + cq * 4);
                const size_t tok = (size_t)b * SEQ + nb * 128 + 32 * qg + row; const int col = h * 64 + 32 * db + cq * 4;
                const u32x2 g = *(const GAS u32x2*)(PROJ + tok * PLD + C_GSWA + col);
                u32x2 w; w.x = pk2(v.x * bflo(g.x), v.y * bfhi(g.x)); w.y = pk2(v.z * bflo(g.y), v.w * bfhi(g.y));
                *(GAS u32x2*)(Y + tok * YLD + 1024 + col) = w; }
            LDS_WAIT(); asm volatile("" ::: "memory");
        }
    }
    __syncthreads();
}

constexpr int ME_KV = 0, ME_PF = 36864, ME_MX = ME_PF + 65536, ME_SM = ME_MX + 1024, ME_LW = ME_SM + 1024, ME_END = ME_LW + 1024, ME_OST = ME_PF;
static_assert(ME_END <= RING_BYTES, "mem LDS");
__device__ __forceinline__ void p2_mem_item(Frame& F, int item) {
    const int b = item >> 6, h = (item >> 4) & 3, qt = item & 15;
    const bf16* PROJ = (const bf16*)(F.ws + WS_PROJ); const bf16* MK = (const bf16*)(F.ws + WS_MK); const bf16* MVT = (const bf16*)(F.ws + WS_MVT); bf16* Y = (bf16*)(F.ws + WS_Y);
    const int tid = F.tid, lane = F.lane, wave = F.wave;
    LAS unsigned char* L = F.lds;
    typedef unsigned u32x2 __attribute__((ext_vector_type(2)));
    const int ql = lane & 31, hi = lane >> 5, qg = wave & 3, wh = wave >> 2;
    const size_t rowq = (size_t)b * SEQ + qt * 128 + 32 * qg + ql;
    const int srow = tid >> 1, shalf = tid & 1;
    v4u pre[4];
    { const GAS v4u* src = (const GAS v4u*)(MK + (size_t)(b * 256 + srow) * 1024 + h * 256 + shalf * 32);
#pragma unroll
      for (int i = 0; i < 4; ++i) pre[i] = src[i]; }
    bf16x8 qf[16];
#pragma unroll
    for (int ks = 0; ks < 16; ++ks) qf[ks] = *(const bf16x8*)(PROJ + rowq * PLD + C_QM + h * 256 + 16 * ks + 8 * hi);
    f32x16 p[4];
#pragma unroll
    for (int si = 0; si < 4; ++si)
#pragma unroll
        for (int r = 0; r < 16; ++r) p[si][r] = 0.f;
#pragma unroll
    for (int c = 0; c < 4; ++c) {
        if (c > 0) __syncthreads();
#pragma unroll
        for (int i = 0; i < 4; ++i) *(LAS v4u*)(L + ME_KV + srow * 144 + shalf * 64 + 16 * i) = pre[i];
        if (c < 3) { const GAS v4u* src = (const GAS v4u*)(MK + (size_t)(b * 256 + srow) * 1024 + h * 256 + 64 * (c + 1) + shalf * 32);
#pragma unroll
            for (int i = 0; i < 4; ++i) pre[i] = src[i]; }
        else { const GAS v4u* src = (const GAS v4u*)(MVT + ((size_t)((b * 4 + h) * 256 + srow) << 8) + shalf * 32);
#pragma unroll
            for (int i = 0; i < 4; ++i) pre[i] = src[i]; }
        __syncthreads();
#pragma unroll
        for (int si = 0; si < 4; ++si)
#pragma unroll
            for (int s = 0; s < 4; ++s) { const bf16x8 kf = *(const LAS bf16x8*)(L + ME_KV + (32 * (4 * wh + si) + ql) * 144 + (16 * s + 8 * hi) * 2);
                p[si] = __builtin_amdgcn_mfma_f32_32x32x16_bf16(kf, qf[4 * c + s], p[si], 0, 0, 0); }
    }
    float mx = -1e30f;
#pragma unroll
    for (int si = 0; si < 4; ++si)
#pragma unroll
        for (int r = 0; r < 16; ++r) mx = __builtin_fmaxf(mx, p[si][r]);
    mx = __builtin_fmaxf(mx, __shfl_xor(mx, 32));
    if (hi == 0) *(LAS float*)(L + ME_MX + (wave * 32 + ql) * 4) = mx;
    __syncthreads();
    mx = __builtin_fmaxf(mx, *(const LAS float*)(L + ME_MX + ((wave ^ 4) * 32 + ql) * 4));
    float sum = 0.f;
#pragma unroll
    for (int si = 0; si < 4; ++si)
#pragma unroll
        for (int r = 0; r < 16; ++r) { p[si][r] = __builtin_amdgcn_exp2f(p[si][r] - mx); sum += p[si][r]; }
    sum += __shfl_xor(sum, 32);
    if (hi == 0) *(LAS float*)(L + ME_SM + (wave * 32 + ql) * 4) = sum;
#pragma unroll
    for (int si = 0; si < 4; ++si)
#pragma unroll
        for (int s2 = 0; s2 < 2; ++s2) { v4u pw; pw.x = cvtpk(p[si][8 * s2 + 0], p[si][8 * s2 + 1]); pw.y = cvtpk(p[si][8 * s2 + 2], p[si][8 * s2 + 3]); pw.z = cvtpk(p[si][8 * s2 + 4], p[si][8 * s2 + 5]); pw.w = cvtpk(p[si][8 * s2 + 6], p[si][8 * s2 + 7]);
            *(LAS v4u*)(L + ME_PF + ((wave * 8 + si * 2 + s2) * 64 + lane) * 16) = pw; }
    f32x16 o[4];
#pragma unroll
    for (int db = 0; db < 4; ++db)
#pragma unroll
        for (int r = 0; r < 16; ++r) o[db][r] = 0.f;
#pragma unroll
    for (int c = 0; c < 4; ++c) {
        if (c > 0) __syncthreads();
        { const u32x2* pp = (const u32x2*)pre;
#pragma unroll
          for (int i = 0; i < 8; ++i) *(LAS u32x2*)(L + ME_KV + srow * 136 + shalf * 64 + 8 * i) = pp[i]; }
        if (c < 3) { const GAS v4u* src = (const GAS v4u*)(MVT + ((size_t)((b * 4 + h) * 256 + srow) << 8) + 64 * (c + 1) + shalf * 32);
#pragma unroll
            for (int i = 0; i < 4; ++i) pre[i] = src[i]; }
        __syncthreads();
#pragma unroll
        for (int s = 0; s < 4; ++s) { const int ks = 4 * c + s;
            const bf16x8 pa = *(const LAS bf16x8*)(L + ME_PF + ((((ks >> 3) * 4 + qg) * 8 + (ks & 7)) * 64 + lane) * 16);
#pragma unroll
            for (int db = 0; db < 4; ++db) { const LAS unsigned char* vp = L + ME_KV + (128 * wh + 32 * db + ql) * 136 + (16 * s + 4 * hi) * 2;
                const u32x2 v0 = *(const LAS u32x2*)vp, v1 = *(const LAS u32x2*)(vp + 16);
                v4u vw; vw.x = v0.x; vw.y = v0.y; vw.z = v1.x; vw.w = v1.y;
                o[db] = __builtin_amdgcn_mfma_f32_32x32x16_bf16(pa, __builtin_bit_cast(bf16x8, vw), o[db], 0, 0, 0); } }
    }
    const float l = *(const LAS float*)(L + ME_SM + (wave * 32 + ql) * 4) + *(const LAS float*)(L + ME_SM + ((wave ^ 4) * 32 + ql) * 4);
    LAS float* lw = (LAS float*)(L + ME_LW) + wave * 32;
    if (hi == 0) lw[ql] = l;
    __syncthreads();
    float rl[16];
#pragma unroll
    for (int r = 0; r < 16; ++r) rl[r] = __builtin_amdgcn_rcpf(lw[(r & 3) + 8 * (r >> 2) + 4 * hi]);
    LAS float* stg = (LAS float*)(L + ME_OST + wave * 4096);
#pragma unroll
    for (int db = 0; db < 4; ++db) {
#pragma unroll
        for (int r = 0; r < 16; ++r) stg[((r & 3) + 8 * (r >> 2) + 4 * hi) * 32 + ql] = o[db][r] * rl[r];
        LDS_WAIT(); asm volatile("" ::: "memory");
#pragma unroll
        for (int i = 0; i < 4; ++i) { const int row = i * 8 + (lane >> 3), cq = lane & 7;
            const f32x4 v = *(const LAS f32x4*)(stg + row * 32 + cq * 4);
            const size_t tok = (size_t)b * SEQ + qt * 128 + 32 * qg + row; const int col = h * 256 + 128 * wh + 32 * db + cq * 4;
            const u32x2 g = *(const GAS u32x2*)(PROJ + tok * PLD + C_GMEM + col);
            u32x2 w; w.x = pk2(v.x * bflo(g.x), v.y * bfhi(g.x)); w.y = pk2(v.z * bflo(g.y), v.w * bfhi(g.y));
            *(GAS u32x2*)(Y + tok * YLD + 2048 + col) = w; }
        LDS_WAIT(); asm volatile("" ::: "memory");
    }
    __syncthreads();
}
__device__ __forceinline__ void p5_final(Frame& F) {
    const float* OUT32 = (const float*)(F.ws + WS_OUT32);
    const int gw = F.vcu * NWAVES + F.wave, NGW = F.G * NWAVES, lane = F.lane;
    for (int m = gw; m < TOK; m += NGW) {
        const GAS f32x4* orow = (const GAS f32x4*)(OUT32 + (size_t)m * DM) + lane; const GAS f32x4* xr = (const GAS f32x4*)(F.in[0] + (size_t)m * DM) + lane;
        const GAS f32x4* gr = (const GAS f32x4*)F.in[3] + lane; GAS f32x4* dst = (GAS f32x4*)(F.out + (size_t)m * DM) + lane;
        f32x4 v[8]; float s = 0.f;
#pragma unroll
        for (int j = 0; j < 8; ++j) { v[j] = orow[64 * j]; s += (v[j].x * v[j].x + v[j].y * v[j].y) + (v[j].z * v[j].z + v[j].w * v[j].w); }
        const float rstd = 1.0f / sqrtf(wave_sum(s) * (1.f / DM) + EPS);
#pragma unroll
        for (int j = 0; j < 8; ++j) dst[64 * j] = xr[64 * j] + v[j] * rstd * gr[64 * j];
    }
}

constexpr int N_PHASES = 8;
struct Args { const float* in[20]; float* out; unsigned char* ws; int ph_lo, ph_hi, use_bar, pad; };
__global__ void __launch_bounds__(NWAVES * 64, 2) hybrid_fwd(Args args) {
    extern __shared__ __attribute__((aligned(16))) unsigned char lds[];
    Frame F;
    F.lds = (LAS unsigned char*)lds;
    F.MISC = (volatile LAS unsigned*)(F.lds + MISC_OFF);
    F.tid = threadIdx.x; F.lane = F.tid & 63; F.wave = __builtin_amdgcn_readfirstlane(F.tid >> 6);
    F.G = gridDim.x; { const int bx = blockIdx.x; F.vcu = (F.G % 8 == 0) ? (bx % 8) * (F.G / 8) + bx / 8 : bx; }
#pragma unroll
    for (int i = 0; i < 20; ++i) F.in[i] = args.in[i];
    F.out = args.out; F.ws = args.ws; F.ctl = (gu32*)(args.ws + WS_CTL);
    for (int u = F.tid; u < (LDS_BYTES - LDSCTL_OFF) / 4; u += NWAVES * 64) ((LAS unsigned*)(F.lds + LDSCTL_OFF))[u] = 0u;
    __syncthreads();
    XcdBarrier bar; bar.bar = (unsigned*)(F.ctl + CW_BAR); bar.x = 0; bar.st = nullptr;
    if (args.use_bar) bar = xcd_barrier_post((unsigned*)(F.ctl + CW_BAR), F.MISC + 8);
    const int lo = args.ph_lo, hi = args.ph_hi;
#define IN(k) (lo <= (k) && (k) < hi)
#define SEAM(k) do { if (IN(k) && IN((k) + 1)) xcd_barrier(bar); } while (0)

    if (IN(0)) { p0_prologue(F); } SEAM(0);
    if (IN(1)) {
        pg8::Gemm g{(const pg8::bf16_t*)(F.ws + WS_H), (const pg8::bf16_t*)(F.ws + WS_WIN), 9216, 14592, DM};
        pg8::OrderP1 S; S.init(F.G, (int)blockIdx.x);
        pg8::EpiP1 E{(pg8::bf16_t*)(F.ws + WS_PROJ), (pg8::bf16_t*)(F.ws + WS_VT), (unsigned short*)(F.ws + WS_GATES), (pg8::bf16_t*)(F.ws + WS_MK), (pg8::bf16_t*)(F.ws + WS_MVT)};
        pg8::gemm_phase<pg8::EpiP1, pg8::OrderP1, PG8_ALIGN, PG8_SP2>(F.lds + RING_OFF, g, S, E);
    } SEAM(1);
    if (IN(2)) { for (int it = F.vcu; it < 256; it += F.G) p2_rglru_item(F, it); for (int it = F.vcu; it < 256; it += F.G) p2_swa_item(F, it); for (int it = F.vcu; it < 256; it += F.G) p2_mem_item(F, it); } SEAM(2);
    if (IN(4)) {
        pg8::Gemm g{(const pg8::bf16_t*)(F.ws + WS_Y), (const pg8::bf16_t*)(F.ws + WS_WBR), TOK, DM, YLD};
        pg8::StaticOrder S; S.init(TOK, DM, F.G, (int)blockIdx.x);
        pg8::EpiP3 E{(const unsigned short*)(F.ws + WS_GATES), (pg8::bf16_t*)(F.ws + WS_MERGED)};
        pg8::gemm_phase<pg8::EpiP3, pg8::StaticOrder, PG8_ALIGN, PG8_SP2>(F.lds + RING_OFF, g, S, E);
    } SEAM(4);
    if (IN(5)) {
        pg8::Gemm g{(const pg8::bf16_t*)(F.ws + WS_MERGED), (const pg8::bf16_t*)(F.ws + WS_WOUT), TOK, DM, DM};
        pg8::StaticOrder S; S.init(TOK, DM, F.G, (int)blockIdx.x);
        pg8::EpiF32 E{(float*)(F.ws + WS_OUT32), DM};
        pg8::gemm_phase<pg8::EpiF32, pg8::StaticOrder, PG8_ALIGN, PG8_SP2>(F.lds + RING_OFF, g, S, E);
    } SEAM(5);
    if (IN(6)) { p5_final(F); }
#undef IN
#undef SEAM
}

extern "C" void kernel_launch(void* const* d_in, const int* in_sizes, int n_in, void* d_out, int out_size, void* d_ws, size_t ws_size, hipStream_t stream) {
    static int grid = 0;
    if (grid == 0) {
        if (n_in != 20 || in_sizes[0] != TOK * DM || out_size != TOK * DM || ws_size < WS_END) { fprintf(stderr, "kernel_launch: unexpected shapes (n_in %d, in0 %d, out %d, ws %zu)\n", n_in, n_in > 0 ? in_sizes[0] : -1, out_size, ws_size); grid = -1; return; }
        int dev = 0, cus = 0, per_cu = 0;
        if (hipGetDevice(&dev) != hipSuccess || hipDeviceGetAttribute(&cus, hipDeviceAttributeMultiprocessorCount, dev) != hipSuccess) { grid = -1; return; }
        if (hipFuncSetAttribute((const void*)hybrid_fwd, hipFuncAttributeMaxDynamicSharedMemorySize, LDS_BYTES) != hipSuccess) { fprintf(stderr, "kernel_launch: hipFuncSetAttribute failed\n"); grid = -1; return; }
        if (hipOccupancyMaxActiveBlocksPerMultiprocessor(&per_cu, (const void*)hybrid_fwd, NWAVES * 64, LDS_BYTES) != hipSuccess || per_cu < 1) { fprintf(stderr, "kernel_launch: occupancy query says %d workgroups per CU\n", per_cu); (void)hipGetLastError(); grid = -1; return; }
        grid = cus;
    }
    if (grid < 0) return;
    if (hipMemsetAsync((char*)d_ws + WS_CTL, 0, CTL_ZERO_BYTES, stream) != hipSuccess) return;
    Args a{};
    for (int i = 0; i < 20; ++i) a.in[i] = (const float*)d_in[i];
    a.out = (float*)d_out; a.ws = (unsigned char*)d_ws;
#ifndef N_LAUNCH_PER_PHASE
#define N_LAUNCH_PER_PHASE 0
#endif
#if N_LAUNCH_PER_PHASE
    for (int p = 0; p < 7; ++p) { a.ph_lo = p; a.ph_hi = p + 1; a.use_bar = 0; hipLaunchKernelGGL(hybrid_fwd, dim3(grid), dim3(NWAVES * 64), LDS_BYTES, stream, a); }
#else
    a.ph_lo = 0; a.ph_hi = 7; a.use_bar = 1; hipLaunchKernelGGL(hybrid_fwd, dim3(grid), dim3(NWAVES * 64), LDS_BYTES, stream, a);
#endif
}
```
